# Optimizing an MI355X kernel written in HIP

```python
import math
import jax, jax.numpy as jnp
from jax import lax
import numpy as np

D_MODEL = 2048
BATCH = 2
SEQ = 4096
DEPTH = 1

D_MIX = D_MODEL
D_SSM = D_MIX // 2
SSM_GROUP = 16
SSM_GROUPS = D_SSM // SSM_GROUP
SSM_STATE = 64
D_SGU = D_MIX - D_SSM
SGU_CHUNK = 128
SGU_HEADS = 8
SGU_HEAD_DIM = D_SGU // SGU_HEADS
D_FFN = -(-8 * D_MODEL // (3 * 256)) * 256
PLE_DIM = 256
EPS = 1e-6
DT_MIN = 1e-3
DT_MAX = 1e-1
LAMBDA_RE_MAX = -1e-4

kernel_name = "hybrid_s5_sgu_parallel_heads"


def rmsnorm(x, g):
    xf = x.astype(jnp.float32)
    r = lax.rsqrt(jnp.mean(xf * xf, axis=-1, keepdims=True) + EPS)
    return (xf * r).astype(x.dtype) * g


def layernorm(x, g, b):
    xf = x.astype(jnp.float32)
    mu = jnp.mean(xf, axis=-1, keepdims=True)
    xc = xf - mu
    r = lax.rsqrt(jnp.mean(xc * xc, axis=-1, keepdims=True) + EPS)
    return (xc * r).astype(x.dtype) * g + b


def _complex_linear_combine(e1, e2):
    a1r, a1i, b1r, b1i = e1
    a2r, a2i, b2r, b2i = e2
    ar = a2r * a1r - a2i * a1i
    ai = a2r * a1i + a2i * a1r
    br = a2r * b1r - a2i * b1i + b2r
    bi = a2r * b1i + a2i * b1r + b2i
    return (ar, ai, br, bi)


def s5_mixer(u, lam_re, lam_im, log_step, b_re, b_im, c_re, c_im, d, glu_w, glu_b):
    bsz, L, _ = u.shape
    f32 = jnp.float32
    ug = u.reshape(bsz, L, SSM_GROUPS, SSM_GROUP).astype(f32)
    lr = jnp.minimum(lam_re.astype(f32), LAMBDA_RE_MAX)
    li = lam_im.astype(f32)
    dt = jnp.exp(log_step.astype(f32))[:, None]
    mag = jnp.exp(lr * dt)
    ang = li * dt
    abar_re = mag * jnp.cos(ang)
    abar_im = mag * jnp.sin(ang)
    nr = abar_re - 1.0
    ni = abar_im
    den = lr * lr + li * li
    q_re = (nr * lr + ni * li) / den
    q_im = (ni * lr - nr * li) / den
    b_re32 = b_re.astype(f32)
    b_im32 = b_im.astype(f32)
    bbar_re = q_re[..., None] * b_re32 - q_im[..., None] * b_im32
    bbar_im = q_re[..., None] * b_im32 + q_im[..., None] * b_re32
    bu_re = jnp.einsum('blgh,gph->blgp', ug, bbar_re)
    bu_im = jnp.einsum('blgh,gph->blgp', ug, bbar_im)
    a_re = jnp.broadcast_to(abar_re, bu_re.shape)
    a_im = jnp.broadcast_to(abar_im, bu_im.shape)
    _, _, s_re, s_im = lax.associative_scan(
        _complex_linear_combine, (a_re, a_im, bu_re, bu_im), axis=1)
    y = (jnp.einsum('blgp,ghp->blgh', s_re, c_re.astype(f32))
         - jnp.einsum('blgp,ghp->blgh', s_im, c_im.astype(f32))
         + d.astype(f32) * ug)
    y = y.reshape(bsz, L, D_SSM).astype(u.dtype)
    y = jax.nn.gelu(y)
    return y * jax.nn.sigmoid(y @ glu_w + glu_b)


def sgu_mixer(u, v, ln_g, ln_b, w_s, b_s):
    bsz, L, _ = u.shape
    u = jax.nn.gelu(u)
    v = layernorm(jax.nn.gelu(v), ln_g, ln_b)
    vc = v.reshape(bsz, L // SGU_CHUNK, SGU_CHUNK, SGU_HEADS, SGU_HEAD_DIM)
    mask = jnp.tril(jnp.ones((SGU_CHUNK, SGU_CHUNK), dtype=bool))
    w = jnp.where(mask[None], w_s, jnp.zeros_like(w_s))
    s = jnp.einsum('hts,bnshc->bnthc', w, vc) + b_s.T[None, None, :, :, None]
    return u * s.reshape(bsz, L, D_SGU)


def setup_inputs(seed: int = 0) -> dict:
    key = jax.random.key(seed)
    ks = jax.random.split(key, 32)
    f32 = jnp.float32
    nrm = lambda k, shape, scale: jax.random.normal(k, shape, f32) * scale
    gain = lambda k, shape: 1.0 + 0.01 * jax.random.normal(k, shape, f32)
    x = jax.random.normal(ks[0], (BATCH, SEQ, D_MODEL), f32)
    p = jax.random.normal(ks[1], (DEPTH, BATCH, SEQ, PLE_DIM), f32)
    norm_mix_g = gain(ks[2], (DEPTH, D_MODEL))
    w_in = nrm(ks[3], (DEPTH, D_MODEL, D_SSM + 2 * D_SGU), D_MODEL ** -0.5)
    ssm_lambda_re = -0.5 + 0.01 * jax.random.normal(ks[4], (DEPTH, SSM_GROUPS, SSM_STATE), f32)
    ssm_lambda_im = (jnp.pi * jnp.arange(SSM_STATE, dtype=f32))[None, None, :] \
        + 0.01 * jax.random.normal(ks[5], (DEPTH, SSM_GROUPS, SSM_STATE), f32)
    ssm_log_step = math.log(DT_MIN) + jax.random.uniform(ks[6], (DEPTH, SSM_GROUPS), f32) \
        * (math.log(DT_MAX) - math.log(DT_MIN))
    bs = (2.0 * SSM_GROUP) ** -0.5
    cs = (2.0 * SSM_STATE) ** -0.5
    ssm_b_re = nrm(ks[7], (DEPTH, SSM_GROUPS, SSM_STATE, SSM_GROUP), bs)
    ssm_b_im = nrm(ks[8], (DEPTH, SSM_GROUPS, SSM_STATE, SSM_GROUP), bs)
    ssm_c_re = nrm(ks[9], (DEPTH, SSM_GROUPS, SSM_GROUP, SSM_STATE), cs)
    ssm_c_im = nrm(ks[10], (DEPTH, SSM_GROUPS, SSM_GROUP, SSM_STATE), cs)
    ssm_d = nrm(ks[11], (DEPTH, SSM_GROUPS, SSM_GROUP), 0.5)
    ssm_glu_w = nrm(ks[12], (DEPTH, D_SSM, D_SSM), D_SSM ** -0.5)
    ssm_glu_b = nrm(ks[13], (DEPTH, D_SSM), 0.01)
    sgu_ln_g = gain(ks[14], (DEPTH, D_SGU))
    sgu_ln_b = nrm(ks[15], (DEPTH, D_SGU), 0.01)
    sgu_w = nrm(ks[16], (DEPTH, SGU_HEADS, SGU_CHUNK, SGU_CHUNK), SGU_CHUNK ** -0.5)
    sgu_b = gain(ks[17], (DEPTH, SGU_HEADS, SGU_CHUNK))
    out_norm_ssm_g = gain(ks[18], (DEPTH, D_SSM))
    out_norm_sgu_g = gain(ks[19], (DEPTH, D_SGU))
    w_out = nrm(ks[20], (DEPTH, D_MIX, D_MODEL), D_MIX ** -0.5)
    norm_ffn_g = gain(ks[21], (DEPTH, D_MODEL))
    w_ffn_in = nrm(ks[22], (DEPTH, D_MODEL, 2 * D_FFN), D_MODEL ** -0.5)
    w_ffn_out = nrm(ks[23], (DEPTH, D_FFN, D_MODEL), D_FFN ** -0.5)
    norm_ple_g = gain(ks[24], (DEPTH, D_MODEL))
    w_ple_gate = nrm(ks[25], (DEPTH, D_MODEL, D_MODEL), D_MODEL ** -0.5)
    b_ple_gate = nrm(ks[26], (DEPTH, D_MODEL), 0.01)
    w_ple_proj = nrm(ks[27], (DEPTH, PLE_DIM, D_MODEL), PLE_DIM ** -0.5)
    final_norm_g = gain(ks[28], (D_MODEL,))
    return {
        "x": x, "p": p, "norm_mix_g": norm_mix_g, "w_in": w_in,
        "ssm_lambda_re": ssm_lambda_re, "ssm_lambda_im": ssm_lambda_im,
        "ssm_log_step": ssm_log_step, "ssm_b_re": ssm_b_re, "ssm_b_im": ssm_b_im,
        "ssm_c_re": ssm_c_re, "ssm_c_im": ssm_c_im, "ssm_d": ssm_d,
        "ssm_glu_w": ssm_glu_w, "ssm_glu_b": ssm_glu_b,
        "sgu_ln_g": sgu_ln_g, "sgu_ln_b": sgu_ln_b, "sgu_w": sgu_w, "sgu_b": sgu_b,
        "out_norm_ssm_g": out_norm_ssm_g, "out_norm_sgu_g": out_norm_sgu_g,
        "w_out": w_out, "norm_ffn_g": norm_ffn_g, "w_ffn_in": w_ffn_in,
        "w_ffn_out": w_ffn_out, "norm_ple_g": norm_ple_g, "w_ple_gate": w_ple_gate,
        "b_ple_gate": b_ple_gate, "w_ple_proj": w_ple_proj, "final_norm_g": final_norm_g,
    }


def reference(x, p, norm_mix_g, w_in, ssm_lambda_re, ssm_lambda_im, ssm_log_step,
              ssm_b_re, ssm_b_im, ssm_c_re, ssm_c_im, ssm_d, ssm_glu_w, ssm_glu_b,
              sgu_ln_g, sgu_ln_b, sgu_w, sgu_b, out_norm_ssm_g, out_norm_sgu_g,
              w_out, norm_ffn_g, w_ffn_in, w_ffn_out, norm_ple_g, w_ple_gate,
              b_ple_gate, w_ple_proj, final_norm_g):
    for i in range(DEPTH):
        h = rmsnorm(x, norm_mix_g[i])
        z = h @ w_in[i]
        z_ssm = z[..., :D_SSM]
        z_u = z[..., D_SSM:D_SSM + D_SGU]
        z_v = z[..., D_SSM + D_SGU:]
        y_a = s5_mixer(z_ssm, ssm_lambda_re[i], ssm_lambda_im[i], ssm_log_step[i],
                       ssm_b_re[i], ssm_b_im[i], ssm_c_re[i], ssm_c_im[i], ssm_d[i],
                       ssm_glu_w[i], ssm_glu_b[i])
        y_b = sgu_mixer(z_u, z_v, sgu_ln_g[i], sgu_ln_b[i], sgu_w[i], sgu_b[i])
        y = jnp.concatenate([rmsnorm(y_a, out_norm_ssm_g[i]),
                             rmsnorm(y_b, out_norm_sgu_g[i])], axis=-1)
        x = x + y @ w_out[i]
        h = rmsnorm(x, norm_ffn_g[i])
        gu = h @ w_ffn_in[i]
        x = x + (jax.nn.silu(gu[..., :D_FFN]) * gu[..., D_FFN:]) @ w_ffn_out[i]
        h = rmsnorm(x, norm_ple_g[i])
        gate = jax.nn.sigmoid(h @ w_ple_gate[i] + b_ple_gate[i])
        x = x + gate * (p[i] @ w_ple_proj[i])
    return rmsnorm(x, final_norm_g)
```

```cpp
#include <hip/hip_runtime.h>
#include <cstdio>
#include <cstdint>

#ifndef MK_N_LAUNCHES
#define MK_N_LAUNCHES 1
#endif

#define LAS __attribute__((address_space(3)))
#define GAS __attribute__((address_space(1)))
typedef unsigned short bf16;
typedef short bf16x8 __attribute__((ext_vector_type(8)));
typedef float f32x4 __attribute__((ext_vector_type(4)));
typedef float f32x2 __attribute__((ext_vector_type(2)));
typedef unsigned u32x4 __attribute__((ext_vector_type(4)));
typedef unsigned u32x2 __attribute__((ext_vector_type(2)));
typedef GAS unsigned gu32;

constexpr int T = 8192;
constexpr int SEQ = 4096;
constexpr int D = 2048, DS = 1024, DG = 1024, NIN = 3072, FF = 5632, PLE = 256;
constexpr int NG = 64, NP = 64, NH = 16;
constexpr int LC = 16;
constexpr int NCH = T / LC;
constexpr int KC = LC * NH + 2 * NP;
constexpr int KA = LC * NH;
constexpr float EPS = 1e-6f;

constexpr size_t MiB = 1u << 20;
constexpr size_t WS_CTL = 0, CTL_ZERO_BYTES = 1 * MiB;
constexpr size_t WS_WFFI = 1 * MiB;
constexpr size_t WS_WFFO = WS_WFFI + 44 * MiB;
constexpr size_t WS_WG   = WS_WFFO + 22 * MiB;
constexpr size_t WS_WPLE = WS_WG + 8 * MiB;
constexpr size_t WS_XB   = WS_WPLE + 1 * MiB;
constexpr size_t WS_PROJ = WS_XB + 32 * MiB;
constexpr size_t WS_SSQA = WS_PROJ + 32 * MiB;
constexpr size_t WS_SSQB = WS_SSQA + 1 * MiB;
constexpr size_t WS_SSQ1 = WS_SSQB + 1 * MiB;
constexpr size_t WS_SSQ2 = WS_SSQ1 + 1 * MiB;
constexpr size_t WS_SSQ3 = WS_SSQ2 + 1 * MiB;
constexpr size_t WS_LNST = WS_SSQ3 + 1 * MiB;
constexpr size_t WS_R0   = WS_LNST + 1 * MiB;
constexpr size_t WS_EARLY = WS_R0 + 1 * MiB;
constexpr size_t WS_WIN  = WS_EARLY;
constexpr size_t WS_WGLU = WS_WIN + 12 * MiB;
constexpr size_t WS_WOUT = WS_WGLU + 2 * MiB;
constexpr size_t WS_TF   = WS_WOUT + 8 * MiB;
constexpr size_t WS_E    = WS_TF + 12 * MiB;
constexpr size_t WS_A16  = WS_E + 5 * MiB;
constexpr size_t WS_AC   = WS_A16 + 1 * MiB;
constexpr size_t WS_GU   = WS_AC + 24 * MiB;
constexpr size_t WS_GV   = WS_GU + 16 * MiB;
constexpr size_t WS_SLOC = WS_GV + 16 * MiB;
constexpr size_t WS_YAPRE = WS_SLOC + 16 * MiB;
constexpr size_t WS_Y    = WS_YAPRE + 16 * MiB;
constexpr size_t WS_PB   = WS_Y + 32 * MiB;
constexpr size_t WS_EARLY_END = WS_PB + 4 * MiB;
constexpr size_t WS_H    = WS_EARLY;
constexpr size_t WS_END  = (WS_EARLY_END > WS_H + 88 * MiB) ? WS_EARLY_END : WS_H + 88 * MiB;

constexpr int CW_BAR = 4096;

constexpr int RING_BYTES = 131072;
constexpr int LDSCTL_OFF = RING_BYTES, MISC_OFF = LDSCTL_OFF + 320;
constexpr int LDS_BYTES = 147456;
constexpr int NWAVES = 8;

#define RLX_AGENT __ATOMIC_RELAXED, __HIP_MEMORY_SCOPE_AGENT
#define LDS_WAIT() asm volatile("s_waitcnt lgkmcnt(0)" ::: "memory")
#define VM_WAIT() asm volatile("s_waitcnt vmcnt(0)" ::: "memory")
__device__ __forceinline__ unsigned cvt_pk_bf16(float lo, float hi) { unsigned r; asm volatile("v_cvt_pk_bf16_f32 %0, %1, %2" : "=v"(r) : "v"(lo), "v"(hi)); return r; }
__device__ __forceinline__ float bf_lo(unsigned w) { return __uint_as_float(w << 16); }
__device__ __forceinline__ float bf_hi(unsigned w) { return __uint_as_float(w & 0xffff0000u); }
__device__ __forceinline__ float fast_sigmoid(float y) { return __builtin_amdgcn_rcpf(1.0f + __builtin_amdgcn_exp2f(-1.4426950408889634f * y)); }
__device__ __forceinline__ float gelu_tanh(float x) { const float y = 1.5957691216057308f * (x + 0.044715f * x * x * x); return x * fast_sigmoid(y); }
__device__ __forceinline__ float silu(float x) { return x * fast_sigmoid(x); }
__device__ __forceinline__ float wave_sum(float v) {
#pragma unroll
    for (int o = 1; o < 64; o <<= 1) v += __shfl_xor(v, o);
    return v;
}

namespace pg8 {
constexpr int BM = 256, BK = 64, HALF = 128, HTB = HALF * BK * 2, NXCD = 8, WGM = 8;
__host__ __device__ __forceinline__ int lds_byte(int r, int c) { const int st = (r >> 4) * 2 + (c >> 5), rr = r & 15, cc = c & 31, ob = rr * 64 + cc * 2; return st * 1024 + (ob ^ (((ob >> 9) & 1) << 5)); }
__host__ __device__ __forceinline__ void stage_rc(int b, int& R, int& C) { const int st = b / 1024, sb = b % 1024, swz = sb ^ (((sb >> 9) & 1) << 5); R = (st >> 1) * 16 + swz / 64; C = (st & 1) * 32 + (swz % 64) / 2; }
__host__ __device__ __forceinline__ int perm32(int rho) { const int n = rho >> 4, i = rho & 15; return 8 * (i >> 2) + 4 * n + (i & 3); }

struct Unit { const char* A; const char* B; int pm, pn, g; };

struct SchedTiles {
    const char* A; const char* B; size_t tstepA, tstepB; int nM, nN, nwg, G, c;
    __device__ __forceinline__ void init(const void* A_, const void* B_, int M, int N, int lda, int ldb, int G_, int c_) {
        A = (const char*)A_; B = (const char*)B_; tstepA = (size_t)BM * lda * 2; tstepB = (size_t)BM * ldb * 2; nM = M / BM; nN = N / BM; nwg = nM * nN; G = G_; c = c_; }
    __device__ __forceinline__ bool next(int i, Unit& u) const {
        const int L = i * G + c; if (L >= nwg) return false;
        int wgid = L; { const int q = nwg / NXCD, r = nwg % NXCD, xcd = wgid % NXCD, off = wgid / NXCD; wgid = (xcd < r ? xcd * (q + 1) : r * (q + 1) + (xcd - r) * q) + off; }
        const int nig = WGM * nN, gid = wgid / nig, fm = gid * WGM, gsz = (nM - fm) < WGM ? (nM - fm) : WGM;
        u.pm = fm + ((wgid % nig) % gsz); u.pn = (wgid % nig) / gsz; u.g = 0;
        u.A = A + (size_t)u.pm * tstepA; u.B = B + (size_t)u.pn * tstepB; return true;
    }
};
struct SchedOne { Unit u; __device__ __forceinline__ bool next(int i, Unit& o) const { if (i != 0) return false; o = u; return true; } };

template <class Epi, class Sched, bool ALIGN_EPI>
__device__ __forceinline__ void gemm_phase(LAS unsigned char* lds, const int K, const int lda, const int ldb, const Sched& S, const Epi& E, int tid) {
    asm volatile("" : "+v"(tid));
    const int wid = __builtin_amdgcn_readfirstlane(tid >> 6), lane = tid & 63, wr = wid >> 2, wc = wid & 3, fr = lane & 15, fq = lane >> 4;
    const int nt = K / BK;
    unsigned voffA[2], voffB[2];
#pragma unroll
    for (int i = 0; i < 2; ++i) { int R, C; stage_rc(tid * 16 + i * 8192, R, C); const int Rb = (R & ~31) + perm32(R & 31);
        voffA[i] = (unsigned)(R * lda + C) * 2u; voffB[i] = (unsigned)(Rb * ldb + C) * 2u; }
    const size_t kstep = (size_t)(BK * 2);
    const size_t hstepA = (size_t)HALF * lda * 2, hstepB = (size_t)HALF * ldb * 2;
    const unsigned ldsw = (unsigned)wid * 1024u;
    const int aoff = lds_byte(wr * 64 + fr, fq * 8), boff = lds_byte(wc * 32 + fr, fq * 8);
#define PG8_SA(b, h) (((b) * 2 + (h)) * HTB)
#define PG8_SB(b, h) ((4 + (b) * 2 + (h)) * HTB)
#define PG8_STAGE(bufoff, gbase, voff) do { _Pragma("unroll") for (int _i = 0; _i < 2; ++_i) \
        __builtin_amdgcn_global_load_lds((const unsigned*)((const char*)(gbase) + (voff)[_i]), (LAS unsigned*)(lds + (bufoff) + ldsw + _i * 8192), 16, 0, 0); } while (0)
#define PG8_LDA(dst, b, h) do { _Pragma("unroll") for (int m = 0; m < 4; ++m) _Pragma("unroll") for (int k = 0; k < 2; ++k) dst[m][k] = *(const LAS bf16x8*)(lds + PG8_SA(b, h) + aoff + m * 2048 + k * 1024); } while (0)
#define PG8_LDB(dst, b, h) do { _Pragma("unroll") for (int n = 0; n < 2; ++n) _Pragma("unroll") for (int k = 0; k < 2; ++k) dst[n][k] = *(const LAS bf16x8*)(lds + PG8_SB(b, h) + boff + n * 2048 + k * 1024); } while (0)
#define PG8_MMA(ai, bj, At, Bt) do { __builtin_amdgcn_s_setprio(1); _Pragma("unroll") for (int m = 0; m < 4; ++m) _Pragma("unroll") for (int n = 0; n < 2; ++n) _Pragma("unroll") for (int k = 0; k < 2; ++k) \
        acc[ai][bj][m][n] = __builtin_amdgcn_mfma_f32_16x16x32_bf16(Bt[n][k], At[m][k], acc[ai][bj][m][n], 0, 0, 0); __builtin_amdgcn_s_setprio(0); } while (0)
#define PG8_WAIT_V(n) asm volatile("s_waitcnt vmcnt(" #n ")" ::: "memory")
#define PG8_WAIT_L(n) asm volatile("s_waitcnt lgkmcnt(" #n ")" ::: "memory")
#define PG8_BAR __builtin_amdgcn_s_barrier()
#define PG8_SCHED __builtin_amdgcn_sched_barrier(0)
    Unit cur, nxt; int ui = 0;
    if (!S.next(0, cur)) return;
    f32x4 acc[2][2][4][2];
#pragma unroll
    for (int a = 0; a < 2; ++a)
#pragma unroll
        for (int b = 0; b < 2; ++b)
#pragma unroll
            for (int m = 0; m < 4; ++m)
#pragma unroll
                for (int n = 0; n < 2; ++n) acc[a][b][m][n] = (f32x4){0.f, 0.f, 0.f, 0.f};
    bf16x8 At[4][2], B0[2][2], B1[2][2];
    const char* cA = cur.A; const char* cB = cur.B;
    PG8_STAGE(PG8_SB(0, 0), cB, voffB); PG8_STAGE(PG8_SB(0, 1), cB + hstepB, voffB); PG8_STAGE(PG8_SA(0, 0), cA, voffA); PG8_STAGE(PG8_SA(0, 1), cA + hstepA, voffA);
    if (wr == 1) PG8_BAR;
    PG8_WAIT_V(2); PG8_BAR;
    PG8_STAGE(PG8_SB(1, 0), cB + kstep, voffB); PG8_STAGE(PG8_SA(1, 0), cA + kstep, voffA); PG8_STAGE(PG8_SB(1, 1), cB + hstepB + kstep, voffB);
    PG8_WAIT_V(6); PG8_BAR;
    for (;;) {
        const bool has_next = S.next(ui + 1, nxt);
        const char* nA = has_next ? nxt.A : cA; const char* nB = has_next ? nxt.B : cB;
        for (int t = 0; t < nt; t += 2) {
            const bool last = (t == nt - 2);
            const char* a1 = cA + (size_t)(t + 1) * kstep;
            const char* a2 = last ? nA : cA + (size_t)(t + 2) * kstep; const char* b2 = last ? nB : cB + (size_t)(t + 2) * kstep;
            const char* a3 = a2 + kstep; const char* b3 = b2 + kstep;
            if constexpr (Epi::MID) { if (t == (nt >> 1)) E.mid(acc, cur, wr, wc, fr, fq); }
            PG8_LDB(B0, 0, 0); PG8_LDB(B1, 0, 1); PG8_SCHED; PG8_LDA(At, 0, 0); PG8_STAGE(PG8_SA(1, 1), a1 + hstepA, voffA);
            PG8_WAIT_V(8); PG8_WAIT_L(0); PG8_BAR; PG8_MMA(0, 0, At, B0); PG8_MMA(0, 1, At, B1); PG8_BAR; PG8_SCHED;
            PG8_LDA(At, 0, 1); PG8_STAGE(PG8_SB(0, 0), b2, voffB); PG8_STAGE(PG8_SB(0, 1), b2 + hstepB, voffB); PG8_STAGE(PG8_SA(0, 0), a2, voffA);
            PG8_WAIT_V(8); PG8_WAIT_L(0); PG8_BAR; PG8_MMA(1, 0, At, B0); PG8_MMA(1, 1, At, B1); PG8_BAR; PG8_SCHED;
            PG8_LDB(B0, 1, 0); PG8_LDB(B1, 1, 1); PG8_SCHED; PG8_LDA(At, 1, 0); PG8_STAGE(PG8_SA(0, 1), a2 + hstepA, voffA);
            PG8_WAIT_V(8); PG8_WAIT_L(0); PG8_BAR; PG8_MMA(0, 0, At, B0); PG8_MMA(0, 1, At, B1); PG8_BAR; PG8_SCHED;
            PG8_LDA(At, 1, 1); PG8_STAGE(PG8_SB(1, 0), b3, voffB); PG8_STAGE(PG8_SB(1, 1), b3 + hstepB, voffB); PG8_STAGE(PG8_SA(1, 0), a3, voffA);
            PG8_WAIT_V(8); PG8_WAIT_L(0); PG8_BAR; PG8_MMA(1, 0, At, B0); PG8_MMA(1, 1, At, B1); PG8_BAR; PG8_SCHED;
        }
        if constexpr (ALIGN_EPI) { if (wr == 0) PG8_BAR; }
        E(acc, cur, wr, wc, fr, fq);
        if (!has_next) break;
#pragma unroll
        for (int a = 0; a < 2; ++a)
#pragma unroll
            for (int b = 0; b < 2; ++b)
#pragma unroll
                for (int m = 0; m < 4; ++m)
#pragma unroll
                    for (int n = 0; n < 2; ++n) acc[a][b][m][n] = (f32x4){0.f, 0.f, 0.f, 0.f};
        cur = nxt; cA = nA; cB = nB; ++ui;
        if constexpr (ALIGN_EPI) { if (wr == 1) PG8_BAR; }
    }
    PG8_WAIT_V(0);
    if constexpr (!ALIGN_EPI) { if (wr == 0) PG8_BAR; }
    PG8_BAR;
#undef PG8_SA
#undef PG8_SB
#undef PG8_STAGE
#undef PG8_LDA
#undef PG8_LDB
#undef PG8_MMA
#undef PG8_WAIT_V
#undef PG8_WAIT_L
#undef PG8_BAR
#undef PG8_SCHED
}
}
using pg8::Unit;

#define EPI_ROWS(ai, m) _Pragma("unroll") for (int ai = 0; ai < 2; ++ai) _Pragma("unroll") for (int m = 0; m < 4; ++m)
typedef f32x4 acc_t[2][2][4][2];
#define EPI_FENCE(m) do { if ((m) & 1) asm volatile("" ::: "memory"); } while (0)

__device__ __forceinline__ u32x4 pack8(f32x4 v0, f32x4 v1) { u32x4 w; w.x = cvt_pk_bf16(v0[0], v0[1]); w.y = cvt_pk_bf16(v0[2], v0[3]); w.z = cvt_pk_bf16(v1[0], v1[1]); w.w = cvt_pk_bf16(v1[2], v1[3]); return w; }
__device__ __forceinline__ float sumsq8(f32x4 a, f32x4 b) { return ((a[0] * a[0] + a[1] * a[1]) + (a[2] * a[2] + a[3] * a[3])) + ((b[0] * b[0] + b[1] * b[1]) + (b[2] * b[2] + b[3] * b[3])); }
__device__ __forceinline__ float sum8(f32x4 a, f32x4 b) { return ((a[0] + a[1]) + (a[2] + a[3])) + ((b[0] + b[1]) + (b[2] + b[3])); }
__device__ __forceinline__ void unpack8(u32x4 w, f32x4& a, f32x4& b) { a = (f32x4){bf_lo(w.x), bf_hi(w.x), bf_lo(w.y), bf_hi(w.y)}; b = (f32x4){bf_lo(w.z), bf_hi(w.z), bf_lo(w.w), bf_hi(w.w)}; }
template <int NPART> __device__ __forceinline__ float row_partials(const float* base, int row, int fq) {
    float s;
    if constexpr (NPART == 32) { const f32x4 a = *(const f32x4*)(base + (size_t)row * 32 + 8 * fq), b = *(const f32x4*)(base + (size_t)row * 32 + 8 * fq + 4); s = sum8(a, b); }
    else if constexpr (NPART == 16) { const f32x4 a = *(const f32x4*)(base + (size_t)row * 16 + 4 * fq); s = (a[0] + a[1]) + (a[2] + a[3]); }
    else { const f32x2 a = *(const f32x2*)(base + (size_t)row * 8 + 2 * fq); s = a[0] + a[1]; }
    s += __shfl_xor(s, 16); s += __shfl_xor(s, 32); return s;
}

struct EpiIn {
    static constexpr bool MID = false;
    const float* r0; bf16* AC; bf16* gu; bf16* gv; float* lnst;
    __device__ __forceinline__ void mid(acc_t&, const Unit&, int, int, int, int) const {}
    __device__ __forceinline__ void operator()(const acc_t& acc, const Unit& u, int wr, int wc, int fr, int fq) const {
        asm volatile("" : "+v"(fr), "+v"(fq));
        const int sect = u.pn >> 2;
        EPI_ROWS(ai, m) {
            const int row = u.pm * 256 + ai * 128 + wr * 64 + m * 16 + fr; const float rs = r0[row];
            float s1 = 0.f, s2 = 0.f;
#pragma unroll
            for (int bj = 0; bj < 2; ++bj) {
                const int col = u.pn * 256 + bj * 128 + wc * 32 + 8 * fq;
                f32x4 v0 = acc[ai][bj][m][0] * rs, v1 = acc[ai][bj][m][1] * rs;
                if (sect == 0) {
                    const int g = col >> 4, hi0 = col & 15, chunk = row >> 4, i = row & 15;
                    *(u32x4*)(AC + ((size_t)(g * NCH + chunk) * KC + i * 16 + hi0)) = pack8(v0, v1);
                } else {
#pragma unroll
                    for (int j = 0; j < 4; ++j) { v0[j] = gelu_tanh(v0[j]); v1[j] = gelu_tanh(v1[j]); }
                    if (sect == 1) *(u32x4*)(gu + (size_t)row * DG + (col - 1024)) = pack8(v0, v1);
                    else { *(u32x4*)(gv + (size_t)row * DG + (col - 2048)) = pack8(v0, v1); s1 += sum8(v0, v1); s2 += sumsq8(v0, v1); }
                }
            }
            if (sect == 2) {
                s1 += __shfl_xor(s1, 16); s1 += __shfl_xor(s1, 32); s2 += __shfl_xor(s2, 16); s2 += __shfl_xor(s2, 32);
                if (fq == 0) *(f32x2*)(lnst + ((size_t)row * 16 + (u.pn - 8) * 4 + wc) * 2) = (f32x2){s1, s2};
            }
        }
    }
};
struct EpiSloc {
    static constexpr bool MID = false;
    float* sloc;
    __device__ __forceinline__ void mid(acc_t&, const Unit&, int, int, int, int) const {}
    __device__ __forceinline__ void operator()(const acc_t& acc, const Unit& u, int wr, int wc, int fr, int fq) const {
        asm volatile("" : "+v"(fr), "+v"(fq));
        EPI_ROWS(ai, m) {
            const int row = u.pm * 256 + ai * 128 + wr * 64 + m * 16 + fr;
            float* o = sloc + ((size_t)(u.g * NCH + row) * 128 + wc * 32 + 8 * fq);
            *(f32x4*)o = acc[ai][0][m][0]; *(f32x4*)(o + 4) = acc[ai][0][m][1];
        }
    }
};
struct EpiS5Out {
    static constexpr bool MID = false;
    const bf16* AC; const float* dvec; bf16* yapre;
    __device__ __forceinline__ void mid(acc_t&, const Unit&, int, int, int, int) const {}
    __device__ __forceinline__ void operator()(const acc_t& acc, const Unit& u, int wr, int wc, int fr, int fq) const {
        asm volatile("" : "+v"(fr), "+v"(fq));
        const int ho0 = 8 * (fq & 1);
        const f32x4 d0 = *(const f32x4*)(dvec + u.g * 16 + ho0), d1 = *(const f32x4*)(dvec + u.g * 16 + ho0 + 4);
        EPI_ROWS(ai, m) {
            const int chunk = u.pm * 256 + ai * 128 + wr * 64 + m * 16 + fr;
#pragma unroll
            for (int bj = 0; bj < 2; ++bj) {
                const int n0 = bj * 128 + wc * 32 + 8 * fq, j = n0 >> 4;
                const u32x4 uw = *(const u32x4*)(AC + ((size_t)(u.g * NCH + chunk) * KC + j * 16 + ho0));
                f32x4 u0, u1; unpack8(uw, u0, u1);
                f32x4 v0 = acc[ai][bj][m][0] + d0 * u0, v1 = acc[ai][bj][m][1] + d1 * u1;
#pragma unroll
                for (int q = 0; q < 4; ++q) { v0[q] = gelu_tanh(v0[q]); v1[q] = gelu_tanh(v1[q]); }
                const int token = chunk * LC + j;
                *(u32x4*)(yapre + (size_t)token * DS + u.g * 16 + ho0) = pack8(v0, v1);
            }
            EPI_FENCE(m);
        }
    }
};
struct EpiGlu {
    static constexpr bool MID = false;
    const bf16* yapre; const float* bias; bf16* Y; float* ssqa;
    __device__ __forceinline__ void mid(acc_t&, const Unit&, int, int, int, int) const {}
    __device__ __forceinline__ void operator()(const acc_t& acc, const Unit& u, int wr, int wc, int fr, int fq) const {
        asm volatile("" : "+v"(fr), "+v"(fq));
        f32x4 bv[2][2];
#pragma unroll
        for (int bj = 0; bj < 2; ++bj) { const int col = u.pn * 256 + bj * 128 + wc * 32 + 8 * fq; bv[bj][0] = *(const f32x4*)(bias + col); bv[bj][1] = *(const f32x4*)(bias + col + 4); }
        EPI_ROWS(ai, m) {
            const int row = u.pm * 256 + ai * 128 + wr * 64 + m * 16 + fr; float ss = 0.f;
#pragma unroll
            for (int bj = 0; bj < 2; ++bj) {
                const int col = u.pn * 256 + bj * 128 + wc * 32 + 8 * fq;
                f32x4 y0, y1; unpack8(*(const u32x4*)(yapre + (size_t)row * DS + col), y0, y1);
                f32x4 v0 = acc[ai][bj][m][0] + bv[bj][0], v1 = acc[ai][bj][m][1] + bv[bj][1];
#pragma unroll
                for (int q = 0; q < 4; ++q) { v0[q] = y0[q] * fast_sigmoid(v0[q]); v1[q] = y1[q] * fast_sigmoid(v1[q]); }
                ss += sumsq8(v0, v1);
                *(u32x4*)(Y + (size_t)row * D + col) = pack8(v0, v1);
            }
            ss += __shfl_xor(ss, 16); ss += __shfl_xor(ss, 32);
            if (fq == 0) ssqa[(size_t)row * 16 + u.pn * 4 + wc] = ss;
            EPI_FENCE(m);
        }
    }
};
struct EpiProj {
    static constexpr bool MID = false;
    bf16* proj;
    __device__ __forceinline__ void mid(acc_t&, const Unit&, int, int, int, int) const {}
    __device__ __forceinline__ void operator()(const acc_t& acc, const Unit& u, int wr, int wc, int fr, int fq) const {
        asm volatile("" : "+v"(fr), "+v"(fq));
        EPI_ROWS(ai, m) {
            const int row = u.pm * 256 + ai * 128 + wr * 64 + m * 16 + fr;
#pragma unroll
            for (int bj = 0; bj < 2; ++bj) { const int col = u.pn * 256 + bj * 128 + wc * 32 + 8 * fq; *(u32x4*)(proj + (size_t)row * D + col) = pack8(acc[ai][bj][m][0], acc[ai][bj][m][1]); }
        }
    }
};
struct EpiOut {
    static constexpr bool MID = true;
    const float* ssqa; const float* ssqb; const float* x; float* xo; bf16* xb; float* ssq1;
    __device__ __forceinline__ void mid(acc_t& acc, const Unit& u, int wr, int wc, int fr, int fq) const {
        asm volatile("" : "+v"(fr), "+v"(fq));
        EPI_ROWS(ai, m) {
            const int row = u.pm * 256 + ai * 128 + wr * 64 + m * 16 + fr;
            const float sa = row_partials<16>(ssqa, row, fq), sb = row_partials<8>(ssqb, row, fq);
            const float ratio = sqrtf((sb * (1.0f / 1024.0f) + EPS) / (sa * (1.0f / 1024.0f) + EPS));
#pragma unroll
            for (int bj = 0; bj < 2; ++bj) { acc[ai][bj][m][0] *= ratio; acc[ai][bj][m][1] *= ratio; }
            EPI_FENCE(m);
        }
    }
    __device__ __forceinline__ void operator()(const acc_t& acc, const Unit& u, int wr, int wc, int fr, int fq) const {
        asm volatile("" : "+v"(fr), "+v"(fq));
        EPI_ROWS(ai, m) {
            const int row = u.pm * 256 + ai * 128 + wr * 64 + m * 16 + fr;
            const float sb = row_partials<8>(ssqb, row, fq); const float rb = 1.0f / sqrtf(sb * (1.0f / 1024.0f) + EPS); float ss = 0.f;
#pragma unroll
            for (int bj = 0; bj < 2; ++bj) {
                const size_t off = (size_t)row * D + u.pn * 256 + bj * 128 + wc * 32 + 8 * fq;
                const f32x4 v0 = *(const f32x4*)(x + off) + acc[ai][bj][m][0] * rb, v1 = *(const f32x4*)(x + off + 4) + acc[ai][bj][m][1] * rb;
                *(f32x4*)(xo + off) = v0; *(f32x4*)(xo + off + 4) = v1; *(u32x4*)(xb + off) = pack8(v0, v1); ss += sumsq8(v0, v1);
            }
            ss += __shfl_xor(ss, 16); ss += __shfl_xor(ss, 32);
            if (fq == 0) ssq1[(size_t)row * 32 + u.pn * 4 + wc] = ss;
            EPI_FENCE(m);
        }
    }
};
struct EpiFfnIn {
    static constexpr bool MID = false;
    const float* ssq1; bf16* h;
    __device__ __forceinline__ void mid(acc_t&, const Unit&, int, int, int, int) const {}
    __device__ __forceinline__ void operator()(const acc_t& acc, const Unit& u, int wr, int wc, int fr, int fq) const {
        asm volatile("" : "+v"(fr), "+v"(fq));
        EPI_ROWS(ai, m) {
            const int row = u.pm * 256 + ai * 128 + wr * 64 + m * 16 + fr;
            const float r1 = 1.0f / sqrtf(row_partials<32>(ssq1, row, fq) * (1.0f / 2048.0f) + EPS);
            f32x4 g0 = acc[ai][0][m][0] * r1, g1 = acc[ai][0][m][1] * r1; const f32x4 u0 = acc[ai][1][m][0] * r1, u1 = acc[ai][1][m][1] * r1;
#pragma unroll
            for (int q = 0; q < 4; ++q) { g0[q] = silu(g0[q]) * u0[q]; g1[q] = silu(g1[q]) * u1[q]; }
            *(u32x4*)(h + (size_t)row * FF + u.pn * 128 + wc * 32 + 8 * fq) = pack8(g0, g1);
            EPI_FENCE(m);
        }
    }
};
struct EpiFfnOut {
    static constexpr bool MID = false;
    float* xo; bf16* xb; float* ssq2;
    __device__ __forceinline__ void mid(acc_t&, const Unit&, int, int, int, int) const {}
    __device__ __forceinline__ void operator()(const acc_t& acc, const Unit& u, int wr, int wc, int fr, int fq) const {
        asm volatile("" : "+v"(fr), "+v"(fq));
        EPI_ROWS(ai, m) {
            const int row = u.pm * 256 + ai * 128 + wr * 64 + m * 16 + fr; float ss = 0.f;
#pragma unroll
            for (int bj = 0; bj < 2; ++bj) {
                const size_t off = (size_t)row * D + u.pn * 256 + bj * 128 + wc * 32 + 8 * fq;
                const f32x4 v0 = *(const f32x4*)(xo + off) + acc[ai][bj][m][0], v1 = *(const f32x4*)(xo + off + 4) + acc[ai][bj][m][1];
                *(f32x4*)(xo + off) = v0; *(f32x4*)(xo + off + 4) = v1; *(u32x4*)(xb + off) = pack8(v0, v1); ss += sumsq8(v0, v1);
            }
            ss += __shfl_xor(ss, 16); ss += __shfl_xor(ss, 32);
            if (fq == 0) ssq2[(size_t)row * 32 + u.pn * 4 + wc] = ss;
            EPI_FENCE(m);
        }
    }
};
struct EpiPle {
    static constexpr bool MID = false;
    const float* ssq2; const float* bias; const bf16* proj; float* xo; float* ssq3;
    __device__ __forceinline__ void mid(acc_t&, const Unit&, int, int, int, int) const {}
    __device__ __forceinline__ void operator()(const acc_t& acc, const Unit& u, int wr, int wc, int fr, int fq) const {
        asm volatile("" : "+v"(fr), "+v"(fq));
        f32x4 bv[2][2];
#pragma unroll
        for (int bj = 0; bj < 2; ++bj) { const int col = u.pn * 256 + bj * 128 + wc * 32 + 8 * fq; bv[bj][0] = *(const f32x4*)(bias + col); bv[bj][1] = *(const f32x4*)(bias + col + 4); }
        EPI_ROWS(ai, m) {
            const int row = u.pm * 256 + ai * 128 + wr * 64 + m * 16 + fr;
            const float r2 = 1.0f / sqrtf(row_partials<32>(ssq2, row, fq) * (1.0f / 2048.0f) + EPS); float ss = 0.f;
#pragma unroll
            for (int bj = 0; bj < 2; ++bj) {
                const size_t off = (size_t)row * D + u.pn * 256 + bj * 128 + wc * 32 + 8 * fq;
                f32x4 p0, p1; unpack8(*(const u32x4*)(proj + off), p0, p1);
                f32x4 v0 = acc[ai][bj][m][0] * r2 + bv[bj][0], v1 = acc[ai][bj][m][1] * r2 + bv[bj][1];
                const f32x4 x0 = *(const f32x4*)(xo + off), x1 = *(const f32x4*)(xo + off + 4);
#pragma unroll
                for (int q = 0; q < 4; ++q) { v0[q] = x0[q] + fast_sigmoid(v0[q]) * p0[q]; v1[q] = x1[q] + fast_sigmoid(v1[q]) * p1[q]; }
                *(f32x4*)(xo + off) = v0; *(f32x4*)(xo + off + 4) = v1; ss += sumsq8(v0, v1);
            }
            ss += __shfl_xor(ss, 16); ss += __shfl_xor(ss, 32);
            if (fq == 0) ssq3[(size_t)row * 32 + u.pn * 4 + wc] = ss;
            EPI_FENCE(m);
        }
    }
};

#define XB_TMO      128
#define XB_XCNT(j)  (256  + 64 * (j))
#define XB_XSUB(j)  (1280 + 64 * (j))
#define XB_XGEN(j)  (2304 + 64 * (j))
#define XB_TOP      3328
#define XB_TOPGEN   3392
#define XCD_BAR_WORDS 3456
#define XB_SPIN_CAP (1u << 18)
__device__ __forceinline__ unsigned xb_ld(unsigned* p)              { return __hip_atomic_load(p, __ATOMIC_RELAXED, __HIP_MEMORY_SCOPE_AGENT); }
__device__ __forceinline__ unsigned xb_add(unsigned* p, unsigned v) { return __hip_atomic_fetch_add(p, v, __ATOMIC_RELAXED, __HIP_MEMORY_SCOPE_AGENT); }
__device__ __forceinline__ unsigned xb_xcc_id() { return (unsigned)__builtin_amdgcn_s_getreg((3 << 11) | 20) & 0xFu; }
#define XB_SPIN(cond, bar) do { unsigned _sp = 0; while (cond) { __builtin_amdgcn_s_sleep(1); \
    if ((++_sp & 255u) == 0u) { if (xb_ld(&(bar)[XB_TMO])) break; if (_sp > XB_SPIN_CAP) { atomicAdd(&(bar)[XB_TMO], 1u); break; } } } } while (0)
struct XcdBarrier { unsigned* bar; unsigned x; volatile LAS unsigned* st; };
__device__ __forceinline__ XcdBarrier xcd_barrier_post(unsigned* bar, volatile LAS unsigned* st) {
    XcdBarrier b; b.bar = bar; b.x = xb_xcc_id(); b.st = st;
    if (threadIdx.x == 0) (void)xb_add(&bar[XB_XCNT(b.x)], 1u);
    return b;
}
__device__ __forceinline__ void xcd_barrier_complete(unsigned* bar, unsigned x, unsigned& nloc, unsigned& nx) {
    const unsigned G = gridDim.x * gridDim.y * gridDim.z;
    unsigned sum, cnt, mine, sp = 0u;
    for (;;) {
        sum = 0u; cnt = 0u; mine = 0u;
#pragma unroll
        for (unsigned j = 0; j < 16; ++j) { const unsigned c = xb_ld(&bar[XB_XCNT(j)]); sum += c; cnt += (c > 0u) ? 1u : 0u; mine = (j == x) ? c : mine; }
        if (sum == G) break;
        __builtin_amdgcn_s_sleep(1);
        if ((++sp & 255u) == 0u) { if (xb_ld(&bar[XB_TMO])) break; if (sp > XB_SPIN_CAP) { atomicAdd(&bar[XB_TMO], 1u); break; } }
    }
    nloc = mine > 0u ? mine : 1u; nx = cnt > 0u ? cnt : 1u;
}
__device__ __forceinline__ void xcd_barrier(const XcdBarrier& b) {
    asm volatile("s_waitcnt vmcnt(0)" ::: "memory");
    __syncthreads();
    if (threadIdx.x == 0) {
        unsigned* bar = b.bar;
        __builtin_amdgcn_s_waitcnt(0);
        unsigned nloc = b.st[0], nx = b.st[1];
        if (nloc == 0u) { xcd_barrier_complete(bar, b.x, nloc, nx); b.st[0] = nloc; b.st[1] = nx; }
        const unsigned old = xb_add(&bar[XB_XSUB(b.x)], 1u);
        const unsigned gen = old / nloc;
        if (old + 1u == (gen + 1u) * nloc) {
            __builtin_amdgcn_fence(__ATOMIC_RELEASE, "agent");
            asm volatile("s_waitcnt vmcnt(0)" ::: "memory");
            const unsigned og = xb_add(&bar[XB_TOP], 1u);
            const unsigned tg = og / nx;
            if (og + 1u == (tg + 1u) * nx) xb_add(&bar[XB_TOPGEN], 1u);
            else XB_SPIN(xb_ld(&bar[XB_TOPGEN]) == tg, bar);
            __builtin_amdgcn_fence(__ATOMIC_ACQUIRE, "agent");
            xb_add(&bar[XB_XGEN(b.x)], 1u);
            asm volatile("s_waitcnt vmcnt(0)" ::: "memory");
        } else {
            XB_SPIN(xb_ld(&bar[XB_XGEN(b.x)]) == gen, bar);
            __builtin_amdgcn_fence(__ATOMIC_ACQUIRE, "agent");
            asm volatile("s_waitcnt vmcnt(0)" ::: "memory");
        }
    }
    __syncthreads();
}

struct Args { const float* in[29]; float* out; unsigned char* ws; int ph_lo, ph_hi, li, pad; };
enum In { I_X = 0, I_P, I_NMIXG, I_WIN, I_LRE, I_LIM, I_LSTEP, I_BRE, I_BIM, I_CRE, I_CIM, I_SD, I_GLUW, I_GLUB, I_LNG, I_LNB, I_SGUW, I_SGUB,
          I_ONSSM, I_ONSGU, I_WOUT, I_NFFNG, I_WFFI, I_WFFO, I_NPLEG, I_WG, I_BG, I_WPLE, I_FNG };

__device__ __forceinline__ void p0_transpose_item(const float* W, int N, const float* gain, bf16* WT, int ldt, int dst_row0, int k0, int n0, LAS float* scr, int lane) {
#pragma unroll 8
    for (int i = 0; i < 32; ++i) { const int kk = 2 * i + (lane >> 5); float v = W[(size_t)(k0 + kk) * N + n0 + (lane & 31)]; if (gain) v *= gain[k0 + kk]; scr[kk * 33 + (lane & 31)] = v; }
    LDS_WAIT(); asm volatile("" ::: "memory");
    const int c = lane & 7;
#pragma unroll
    for (int j = 0; j < 4; ++j) { const int n = (lane >> 3) + 8 * j; const LAS float* s = scr + (8 * c) * 33 + n;
        u32x4 o; o.x = cvt_pk_bf16(s[0 * 33], s[1 * 33]); o.y = cvt_pk_bf16(s[2 * 33], s[3 * 33]); o.z = cvt_pk_bf16(s[4 * 33], s[5 * 33]); o.w = cvt_pk_bf16(s[6 * 33], s[7 * 33]);
        *(u32x4*)(WT + (size_t)(dst_row0 + n) * ldt + k0 + 8 * c) = o; }
    LDS_WAIT(); asm volatile("" ::: "memory");
}
template <int MODE>
__device__ __forceinline__ void p0_transpose(const float* W, int K, int N, const float* gain, const float* gain2, bf16* WT, LAS float* scr, int gw, int ngw, int lane) {
    const int nblk = N / 32, nitems = (K / 64) * nblk;
    for (int it = gw; it < nitems; it += ngw) {
        const int kb = it / nblk, nb = it % nblk, k0 = 64 * kb, n0 = 32 * nb;
        int dst = n0;
        if (MODE == 1) { const int half = (n0 >= FF) ? 1 : 0, j = n0 - half * FF; dst = 256 * (j >> 7) + 128 * half + (j & 127); }
        const float* g = gain; if (gain2 && k0 >= 1024) g = gain2 - 1024;
        p0_transpose_item(W, N, g, WT, K, dst, k0, n0, scr, lane);
    }
}
__device__ __forceinline__ void p0_s5_tables(const Args& a, int g, LAS float* L, int tid) {
    LAS float* apow = L;
    LAS float* Bb = L + 2176;
    LAS float* Cc = L + 2176 + 2048;
    LAS float* Kk = L + 2176 + 4096;
    bf16* TF = (bf16*)(a.ws + WS_TF) + (size_t)g * 256 * KC;
    bf16* E = (bf16*)(a.ws + WS_E) + (size_t)g * 128 * KA;
    float* A16 = (float*)(a.ws + WS_A16) + (size_t)g * NP * 2;
    if (tid < NP) {
        const int p = tid;
        const double lr = fmin((double)a.in[I_LRE][g * NP + p], -1e-4), li = (double)a.in[I_LIM][g * NP + p];
        const double dt = exp((double)a.in[I_LSTEP][g]);
        for (int k = 0; k <= LC; ++k) { const double mg = exp(lr * dt * k); double sn, cs; sincos(li * dt * k, &sn, &cs); apow[(k * NP + p) * 2] = (float)(mg * cs); apow[(k * NP + p) * 2 + 1] = (float)(mg * sn); }
        const double mg = exp(lr * dt); double sn, cs; sincos(li * dt, &sn, &cs);
        const double nr = mg * cs - 1.0, ni = mg * sn, den = lr * lr + li * li;
        const double qre = (nr * lr + ni * li) / den, qim = (ni * lr - nr * li) / den;
        for (int h = 0; h < NH; ++h) { const double br = (double)a.in[I_BRE][(g * NP + p) * NH + h], bi = (double)a.in[I_BIM][(g * NP + p) * NH + h];
            Bb[(p * NH + h) * 2] = (float)(qre * br - qim * bi); Bb[(p * NH + h) * 2 + 1] = (float)(qre * bi + qim * br); }
        A16[p * 2] = apow[(LC * NP + p) * 2]; A16[p * 2 + 1] = apow[(LC * NP + p) * 2 + 1];
    }
    for (int e = tid; e < NH * NP; e += 512) { Cc[e * 2] = a.in[I_CRE][g * NH * NP + e]; Cc[e * 2 + 1] = a.in[I_CIM][g * NH * NP + e]; }
    __syncthreads();
    for (int e = tid; e < LC * 256; e += 512) {
        const int k = e >> 8, ho = (e >> 4) & 15, hi = e & 15; float s = 0.f;
        for (int p = 0; p < NP; ++p) {
            const float cr = Cc[(ho * NP + p) * 2], ci = Cc[(ho * NP + p) * 2 + 1], ar = apow[(k * NP + p) * 2], ai = apow[(k * NP + p) * 2 + 1], br = Bb[(p * NH + hi) * 2], bi = Bb[(p * NH + hi) * 2 + 1];
            const float zr = cr * ar - ci * ai, zi = cr * ai + ci * ar;
            s += zr * br - zi * bi;
        }
        Kk[e] = s;
    }
    __syncthreads();
    for (int e = tid; e < 256 * (KC / 2); e += 512) {
        const int row = e / (KC / 2), kc = (e % (KC / 2)) * 2, j = row >> 4, ho = row & 15; float v[2];
#pragma unroll
        for (int q = 0; q < 2; ++q) { const int k = kc + q;
            if (k < 256) { const int i = k >> 4, hi = k & 15; v[q] = (i <= j) ? Kk[((j - i) * 16 + ho) * 16 + hi] : 0.f; }
            else { const int p = (k - 256) & 63, ri = (k - 256) >> 6; const float cr = Cc[(ho * NP + p) * 2], ci = Cc[(ho * NP + p) * 2 + 1], ar = apow[((j + 1) * NP + p) * 2], ai = apow[((j + 1) * NP + p) * 2 + 1];
                v[q] = ri == 0 ? (cr * ar - ci * ai) : -(cr * ai + ci * ar); } }
        *(unsigned*)(TF + (size_t)row * KC + kc) = cvt_pk_bf16(v[0], v[1]);
    }
    for (int e = tid; e < 128 * (KA / 2); e += 512) {
        const int row = e / (KA / 2), kc = (e % (KA / 2)) * 2, ri = row >> 6, p = row & 63; float v[2];
#pragma unroll
        for (int q = 0; q < 2; ++q) { const int k = kc + q, i = k >> 4, hi = k & 15; const float ar = apow[((LC - 1 - i) * NP + p) * 2], ai = apow[((LC - 1 - i) * NP + p) * 2 + 1], br = Bb[(p * NH + hi) * 2], bi = Bb[(p * NH + hi) * 2 + 1];
            v[q] = ri == 0 ? (ar * br - ai * bi) : (ar * bi + ai * br); }
        *(unsigned*)(E + (size_t)row * KA + kc) = cvt_pk_bf16(v[0], v[1]);
    }
    __syncthreads();
}

__device__ __forceinline__ void s5_scan(const Args& a, int g, int b, LAS unsigned char* lds, int wave, int lane) {
    asm volatile("" : "+v"(lane));
    const float* sloc = (const float*)(a.ws + WS_SLOC) + (size_t)(g * NCH + b * 256 + wave * 32) * 128;
    bf16* AC = (bf16*)(a.ws + WS_AC) + (size_t)(g * NCH + b * 256 + wave * 32) * KC + 256;
    const float* A16 = (const float*)(a.ws + WS_A16) + (size_t)g * NP * 2;
    const float ar = A16[lane * 2], ai = A16[lane * 2 + 1];
    float xr[32], xi[32];
#pragma unroll
    for (int j = 0; j < 32; ++j) { xr[j] = sloc[j * 128 + lane]; xi[j] = sloc[j * 128 + 64 + lane]; }
    float sr = 0.f, si = 0.f;
#pragma unroll
    for (int j = 0; j < 32; ++j) { const float nr = ar * sr - ai * si + xr[j], ni = ar * si + ai * sr + xi[j]; sr = nr; si = ni; }
    LAS float* ex = (LAS float*)lds;
    ex[(wave * 64 + lane) * 2] = sr; ex[(wave * 64 + lane) * 2 + 1] = si;
    float pr = ar, pi = ai;
#pragma unroll
    for (int q = 0; q < 5; ++q) { const float nr = pr * pr - pi * pi, ni = 2.f * pr * pi; pr = nr; pi = ni; }
    __syncthreads();
    float cr = 0.f, ci = 0.f;
    for (int v = 0; v < wave; ++v) { const float er = ex[(v * 64 + lane) * 2], ei = ex[(v * 64 + lane) * 2 + 1]; const float nr = pr * cr - pi * ci + er, ni = pr * ci + pi * cr + ei; cr = nr; ci = ni; }
    sr = cr; si = ci;
#pragma unroll
    for (int j = 0; j < 32; ++j) {
        AC[(size_t)j * KC + lane] = (bf16)(cvt_pk_bf16(sr, 0.f) & 0xffffu); AC[(size_t)j * KC + 64 + lane] = (bf16)(cvt_pk_bf16(si, 0.f) & 0xffffu);
        const float nr = ar * sr - ai * si + xr[j], ni = ar * si + ai * sr + xi[j]; sr = nr; si = ni;
    }
    VM_WAIT(); __syncthreads();
}

constexpr int SGU_LDV = 136;
__device__ __forceinline__ void sgu_unit(const Args& a, int n, int h, LAS unsigned char* lds, int tid, int wave, int lane) {
    asm volatile("" : "+v"(tid), "+v"(lane));
    LAS bf16* Vt = (LAS bf16*)lds;
    LAS float* st = (LAS float*)(lds + 36864);
    const int tok0 = n * 128, fr = lane & 15, fq = lane >> 4;
    const bf16* gv = (const bf16*)(a.ws + WS_GV); const bf16* gu = (const bf16*)(a.ws + WS_GU); bf16* Y = (bf16*)(a.ws + WS_Y);
    if (tid < 128) {
        const float* ls = (const float*)(a.ws + WS_LNST) + (size_t)(tok0 + tid) * 32; float s1 = 0.f, s2 = 0.f;
#pragma unroll
        for (int q = 0; q < 8; ++q) { const f32x4 v = *(const f32x4*)(ls + 4 * q); s1 += v[0] + v[2]; s2 += v[1] + v[3]; }
        const float mu = s1 * (1.0f / 1024.0f), var = s2 * (1.0f / 1024.0f) - mu * mu;
        st[tid * 2] = mu; st[tid * 2 + 1] = 1.0f / sqrtf(var + EPS);
    }
    __syncthreads();
#pragma unroll
    for (int i = 0; i < 4; ++i) {
        const int q = tid + 512 * i, s = q & 127, c8 = q >> 7;
        const u32x4 w = *(const u32x4*)(gv + (size_t)(tok0 + s) * DG + h * 128 + 8 * c8);
        f32x4 v0, v1; unpack8(w, v0, v1);
        const f32x4 g0 = *(const f32x4*)(a.in[I_LNG] + h * 128 + 8 * c8), g1 = *(const f32x4*)(a.in[I_LNG] + h * 128 + 8 * c8 + 4);
        const f32x4 b0 = *(const f32x4*)(a.in[I_LNB] + h * 128 + 8 * c8), b1 = *(const f32x4*)(a.in[I_LNB] + h * 128 + 8 * c8 + 4);
        const float mu = st[s * 2], rstd = st[s * 2 + 1];
        v0 = (v0 - mu) * rstd * g0 + b0; v1 = (v1 - mu) * rstd * g1 + b1;
        const unsigned p0 = cvt_pk_bf16(v0[0], v0[1]), p1 = cvt_pk_bf16(v0[2], v0[3]), p2 = cvt_pk_bf16(v1[0], v1[1]), p3 = cvt_pk_bf16(v1[2], v1[3]);
        LAS bf16* d = Vt + (8 * c8) * SGU_LDV + s;
        d[0 * SGU_LDV] = (bf16)(p0 & 0xffffu); d[1 * SGU_LDV] = (bf16)(p0 >> 16); d[2 * SGU_LDV] = (bf16)(p1 & 0xffffu); d[3 * SGU_LDV] = (bf16)(p1 >> 16);
        d[4 * SGU_LDV] = (bf16)(p2 & 0xffffu); d[5 * SGU_LDV] = (bf16)(p2 >> 16); d[6 * SGU_LDV] = (bf16)(p3 & 0xffffu); d[7 * SGU_LDV] = (bf16)(p3 >> 16);
    }
    __syncthreads();
    f32x4 acc[8];
#pragma unroll
    for (int j = 0; j < 8; ++j) acc[j] = (f32x4){0.f, 0.f, 0.f, 0.f};
    const int t = 16 * wave + fr;
    const float* wrow = a.in[I_SGUW] + ((size_t)h * 128 + t) * 128;
#pragma unroll
    for (int kk = 0; kk < 4; ++kk) {
        if (32 * kk <= 16 * wave + 15) {
            const int s0 = 32 * kk + 8 * fq;
            f32x4 w0 = *(const f32x4*)(wrow + s0), w1 = *(const f32x4*)(wrow + s0 + 4);
#pragma unroll
            for (int q = 0; q < 4; ++q) { if (s0 + q > t) w0[q] = 0.f; if (s0 + 4 + q > t) w1[q] = 0.f; }
            const u32x4 aw = pack8(w0, w1); bf16x8 af; __builtin_memcpy(&af, &aw, 16);
#pragma unroll
            for (int j = 0; j < 8; ++j) {
                const bf16x8 bfr = *(const LAS bf16x8*)(Vt + (16 * j + fr) * SGU_LDV + 32 * kk + 8 * fq);
                acc[j] = __builtin_amdgcn_mfma_f32_16x16x32_bf16(bfr, af, acc[j], 0, 0, 0);
            }
        }
    }
    const float bias = a.in[I_SGUB][h * 128 + t]; float ss = 0.f;
    const size_t tok = (size_t)(tok0 + t);
#pragma unroll
    for (int j = 0; j < 8; ++j) {
        const int c = h * 128 + 16 * j + 4 * fq;
        const u32x2 gw = *(const u32x2*)(gu + tok * DG + c);
        f32x4 o; o[0] = (acc[j][0] + bias) * bf_lo(gw.x); o[1] = (acc[j][1] + bias) * bf_hi(gw.x); o[2] = (acc[j][2] + bias) * bf_lo(gw.y); o[3] = (acc[j][3] + bias) * bf_hi(gw.y);
        ss += (o[0] * o[0] + o[1] * o[1]) + (o[2] * o[2] + o[3] * o[3]);
        u32x2 ow; ow.x = cvt_pk_bf16(o[0], o[1]); ow.y = cvt_pk_bf16(o[2], o[3]);
        *(u32x2*)(Y + tok * D + 1024 + c) = ow;
    }
    ss += __shfl_xor(ss, 16); ss += __shfl_xor(ss, 32);
    if (fq == 0) ((float*)(a.ws + WS_SSQB))[tok * 8 + h] = ss;
    __syncthreads();
}

constexpr int PER_PHASE = 9;
__global__ void __launch_bounds__(NWAVES * 64, 2) hybrid_fwd(Args args) {
    extern __shared__ __attribute__((aligned(16))) unsigned char lds_raw[];
    LAS unsigned char* lds = (LAS unsigned char*)lds_raw;
    volatile LAS unsigned* MISC = (volatile LAS unsigned*)(lds + MISC_OFF);
    const int tid = threadIdx.x, lane = tid & 63, wave = __builtin_amdgcn_readfirstlane(tid >> 6);
    const int G = gridDim.x, bx = blockIdx.x;
    const int vcu = (G % 8 == 0) ? (bx % 8) * (G / 8) + bx / 8 : bx;
    unsigned char* ws = args.ws;
    for (int u = tid; u < (LDS_BYTES - LDSCTL_OFF) / 4; u += NWAVES * 64) ((LAS unsigned*)(lds + LDSCTL_OFF))[u] = 0u;
    __syncthreads();
    XcdBarrier bar; bar.bar = (unsigned*)(ws + WS_CTL) + CW_BAR + args.li * XCD_BAR_WORDS; bar.x = 0; bar.st = nullptr;
    if (MK_N_LAUNCHES != PER_PHASE) bar = xcd_barrier_post((unsigned*)(ws + WS_CTL) + CW_BAR + args.li * XCD_BAR_WORDS, MISC + 8);
    const int lo = args.ph_lo, hi = args.ph_hi;
#ifndef PHASE_MASK
#define PHASE_MASK 0x1ff
#endif
#define IN(k) (((PHASE_MASK >> (k)) & 1) && lo <= (k) && (k) < hi)
#define SEAM(k) do { if (IN(k) && IN((k) + 1)) xcd_barrier(bar); } while (0)
    const int gw = vcu * NWAVES + wave, ngw = G * NWAVES;
    const bool split = (G == 256);
    const int roleA = split ? (((bx >> 3) & 1) == 0) : 1, roleB = split ? !roleA : 1;
    const int ridx = split ? (((bx >> 4) << 3) | (bx & 7)) : bx, RG = split ? 128 : G;

    bf16* WT_in = (bf16*)(ws + WS_WIN); bf16* WT_glu = (bf16*)(ws + WS_WGLU); bf16* WT_out = (bf16*)(ws + WS_WOUT); bf16* WT_ffi = (bf16*)(ws + WS_WFFI);
    bf16* WT_ffo = (bf16*)(ws + WS_WFFO); bf16* WT_g = (bf16*)(ws + WS_WG); bf16* WT_ple = (bf16*)(ws + WS_WPLE);
    bf16* XB = (bf16*)(ws + WS_XB); bf16* PB = (bf16*)(ws + WS_PB); bf16* AC = (bf16*)(ws + WS_AC);

    if (IN(0)) {
        LAS float* scr = (LAS float*)(lds + wave * 16384);
        if (bx < NG) p0_s5_tables(args, bx, (LAS float*)lds, tid);
        p0_transpose<0>(args.in[I_WIN], D, NIN, args.in[I_NMIXG], nullptr, WT_in, scr, gw, ngw, lane);
        p0_transpose<0>(args.in[I_GLUW], DS, DS, nullptr, nullptr, WT_glu, scr, gw, ngw, lane);
        p0_transpose<0>(args.in[I_WOUT], D, D, args.in[I_ONSSM], args.in[I_ONSGU], WT_out, scr, gw, ngw, lane);
        p0_transpose<1>(args.in[I_WFFI], D, 2 * FF, args.in[I_NFFNG], nullptr, WT_ffi, scr, gw, ngw, lane);
        p0_transpose<0>(args.in[I_WFFO], FF, D, nullptr, nullptr, WT_ffo, scr, gw, ngw, lane);
        p0_transpose<0>(args.in[I_WG], D, D, args.in[I_NPLEG], nullptr, WT_g, scr, gw, ngw, lane);
        p0_transpose<0>(args.in[I_WPLE], PLE, D, nullptr, nullptr, WT_ple, scr, gw, ngw, lane);
        float* r0 = (float*)(ws + WS_R0);
        for (int m = gw; m < T; m += ngw) {
            const f32x4* xr = (const f32x4*)(args.in[I_X] + (size_t)m * D) + lane; u32x2* o = (u32x2*)(XB + (size_t)m * D) + lane; float ss = 0.f;
#pragma unroll
            for (int j = 0; j < 8; ++j) { const f32x4 v = xr[64 * j]; ss += (v[0] * v[0] + v[1] * v[1]) + (v[2] * v[2] + v[3] * v[3]); u32x2 w; w.x = cvt_pk_bf16(v[0], v[1]); w.y = cvt_pk_bf16(v[2], v[3]); o[64 * j] = w; }
            ss = wave_sum(ss);
            if (lane == 0) r0[m] = 1.0f / sqrtf(ss * (1.0f / 2048.0f) + EPS);
        }
        for (int e = gw * 64 + lane; e < T * PLE / 8; e += ngw * 64) { const f32x4 v0 = *((const f32x4*)args.in[I_P] + 2 * e), v1 = *((const f32x4*)args.in[I_P] + 2 * e + 1); *((u32x4*)PB + e) = pack8(v0, v1); }
    }
    SEAM(0);
    if (IN(1)) {
        pg8::SchedTiles S; S.init(XB, WT_in, T, NIN, D, D, G, bx);
        EpiIn E{(const float*)(ws + WS_R0), AC, (bf16*)(ws + WS_GU), (bf16*)(ws + WS_GV), (float*)(ws + WS_LNST)};
        pg8::gemm_phase<EpiIn, pg8::SchedTiles, true>(lds, D, D, D, S, E, tid);
    }
    SEAM(1);
    if (IN(2)) {
#ifndef P2_SKIP_A
        if (roleA) {
            for (int un = ridx; un < 2 * NG; un += RG) {
                const int g = un >> 1, b = un & 1;
                pg8::SchedOne S; S.u.A = (const char*)(AC + (size_t)(g * NCH + b * 256) * KC); S.u.pm = b; S.u.pn = 0; S.u.g = g;
                S.u.B = (const char*)((const bf16*)(ws + WS_E) + (size_t)g * 128 * KA);
                EpiSloc E1{(float*)(ws + WS_SLOC)};
                pg8::gemm_phase<EpiSloc, pg8::SchedOne, false>(lds, KA, KC, KA, S, E1, tid);
                VM_WAIT(); __syncthreads();
                s5_scan(args, g, b, lds, wave, lane);
                S.u.B = (const char*)((const bf16*)(ws + WS_TF) + (size_t)g * 256 * KC);
                EpiS5Out E2{AC, args.in[I_SD], (bf16*)(ws + WS_YAPRE)};
                pg8::gemm_phase<EpiS5Out, pg8::SchedOne, false>(lds, KC, KC, KC, S, E2, tid);
                __syncthreads();
            }
        }
#endif
#ifndef P2_SKIP_B
        if (roleB) {
            for (int un = ridx; un < 512; un += RG) sgu_unit(args, un >> 3, un & 7, lds, tid, wave, lane);
        }
#endif
    }
    SEAM(2);
    if (IN(3)) {
        if (roleA) {
            pg8::SchedTiles S; S.init((const bf16*)(ws + WS_YAPRE), WT_glu, T, DS, DS, DS, RG, ridx);
            EpiGlu E{(const bf16*)(ws + WS_YAPRE), args.in[I_GLUB], (bf16*)(ws + WS_Y), (float*)(ws + WS_SSQA)};
            pg8::gemm_phase<EpiGlu, pg8::SchedTiles, true>(lds, DS, DS, DS, S, E, tid);
        }
        if (roleB) {
            pg8::SchedTiles S; S.init(PB, WT_ple, T, D, PLE, PLE, RG, ridx);
            EpiProj E{(bf16*)(ws + WS_PROJ)};
            pg8::gemm_phase<EpiProj, pg8::SchedTiles, true>(lds, PLE, PLE, PLE, S, E, tid);
        }
    }
    SEAM(3);
    if (IN(4)) {
        pg8::SchedTiles S; S.init((const bf16*)(ws + WS_Y), WT_out, T, D, D, D, G, bx);
        EpiOut E{(const float*)(ws + WS_SSQA), (const float*)(ws + WS_SSQB), args.in[I_X], args.out, XB, (float*)(ws + WS_SSQ1)};
        pg8::gemm_phase<EpiOut, pg8::SchedTiles, true>(lds, D, D, D, S, E, tid);
    }
    SEAM(4);
    if (IN(5)) {
        pg8::SchedTiles S; S.init(XB, WT_ffi, T, 2 * FF, D, D, G, bx);
        EpiFfnIn E{(const float*)(ws + WS_SSQ1), (bf16*)(ws + WS_H)};
        pg8::gemm_phase<EpiFfnIn, pg8::SchedTiles, true>(lds, D, D, D, S, E, tid);
    }
    SEAM(5);
    if (IN(6)) {
        pg8::SchedTiles S; S.init((const bf16*)(ws + WS_H), WT_ffo, T, D, FF, FF, G, bx);
        EpiFfnOut E{args.out, XB, (float*)(ws + WS_SSQ2)};
        pg8::gemm_phase<EpiFfnOut, pg8::SchedTiles, true>(lds, FF, FF, FF, S, E, tid);
    }
    SEAM(6);
    if (IN(7)) {
        pg8::SchedTiles S; S.init(XB, WT_g, T, D, D, D, G, bx);
        EpiPle E{(const float*)(ws + WS_SSQ2), args.in[I_BG], (const bf16*)(ws + WS_PROJ), args.out, (float*)(ws + WS_SSQ3)};
        pg8::gemm_phase<EpiPle, pg8::SchedTiles, true>(lds, D, D, D, S, E, tid);
    }
    SEAM(7);
    if (IN(8)) {
        const float* ssq3 = (const float*)(ws + WS_SSQ3);
        for (int m = gw; m < T; m += ngw) {
            float s = (lane < 32) ? ssq3[(size_t)m * 32 + lane] : 0.f; s = wave_sum(s);
            const float r = 1.0f / sqrtf(s * (1.0f / 2048.0f) + EPS);
            f32x4* xr = (f32x4*)(args.out + (size_t)m * D) + lane; const f32x4* gr = (const f32x4*)args.in[I_FNG] + lane;
#pragma unroll
            for (int j = 0; j < 8; ++j) { const f32x4 v = xr[64 * j] * r * gr[64 * j]; xr[64 * j] = v; }
        }
    }
#undef IN
#undef SEAM
}

extern "C" void kernel_launch(void* const* d_in, const int* in_sizes, int n_in, void* d_out, int out_size, void* d_ws, size_t ws_size, hipStream_t stream) {
    static int grid = 0;
    if (grid == 0) {
        if (n_in != 29 || in_sizes[0] != T * D || out_size != T * D || ws_size < WS_END) {
            fprintf(stderr, "kernel_launch: shape/workspace mismatch: n_in %d in0 %d out %d ws %zu (need %zu); nothing launched\n", n_in, n_in > 0 ? in_sizes[0] : -1, out_size, ws_size, (size_t)WS_END); grid = -1; return; }
        int dev = 0, cus = 0, per_cu = 0;
        if (hipGetDevice(&dev) != hipSuccess || hipDeviceGetAttribute(&cus, hipDeviceAttributeMultiprocessorCount, dev) != hipSuccess) { fprintf(stderr, "kernel_launch: device query failed\n"); grid = -1; return; }
        if (hipFuncSetAttribute((const void*)hybrid_fwd, hipFuncAttributeMaxDynamicSharedMemorySize, LDS_BYTES) != hipSuccess) { fprintf(stderr, "kernel_launch: hipFuncSetAttribute failed\n"); grid = -1; return; }
        if (hipOccupancyMaxActiveBlocksPerMultiprocessor(&per_cu, (const void*)hybrid_fwd, NWAVES * 64, LDS_BYTES) != hipSuccess || per_cu < 1) { fprintf(stderr, "kernel_launch: occupancy query says %d blocks per CU; nothing launched\n", per_cu); (void)hipGetLastError(); grid = -1; return; }
        grid = cus;
        fprintf(stderr, "kernel_launch: grid %d (CUs %d, occupancy %d/CU), ws need %zu have %zu\n", grid, cus, per_cu, (size_t)WS_END, ws_size);
    }
    if (grid < 0) return;
    if (hipMemsetAsync((char*)d_ws + WS_CTL, 0, CTL_ZERO_BYTES, stream) != hipSuccess) { fprintf(stderr, "kernel_launch: memset failed\n"); return; }
    Args a{};
    for (int i = 0; i < 29; ++i) a.in[i] = (const float*)d_in[i];
    a.out = (float*)d_out; a.ws = (unsigned char*)d_ws;
    if (MK_N_LAUNCHES == 1) {
        a.ph_lo = 0; a.ph_hi = PER_PHASE; a.li = 0;
        void* kargs[] = {&a};
        const hipError_t le = hipLaunchCooperativeKernel((const void*)hybrid_fwd, dim3(grid), dim3(NWAVES * 64), kargs, LDS_BYTES, stream);
        if (le != hipSuccess) fprintf(stderr, "kernel_launch: cooperative launch failed: %s (grid %d)\n", hipGetErrorName(le), grid);
    } else {
        for (int li = 0; li < PER_PHASE; ++li) {
            a.ph_lo = li; a.ph_hi = li + 1; a.li = 0;
            hipLaunchKernelGGL(hybrid_fwd, dim3(grid), dim3(NWAVES * 64), LDS_BYTES, stream, a);
            const hipError_t le = hipPeekAtLastError();
            if (le != hipSuccess) { fprintf(stderr, "kernel_launch: launch %d failed: %s\n", li, hipGetErrorName(le)); break; }
        }
    }
}
```

```cpp
#include <hip/hip_runtime.h>
#include <cstdio>
#include <cstdint>

#ifndef MK_N_LAUNCHES
#define MK_N_LAUNCHES 1
#endif

#define LAS __attribute__((address_space(3)))
#define GAS __attribute__((address_space(1)))
typedef unsigned short bf16;
typedef short bf16x8 __attribute__((ext_vector_type(8)));
typedef float f32x4 __attribute__((ext_vector_type(4)));
typedef float f32x2 __attribute__((ext_vector_type(2)));
typedef unsigned u32x4 __attribute__((ext_vector_type(4)));
typedef unsigned u32x2 __attribute__((ext_vector_type(2)));
typedef GAS unsigned gu32;

constexpr int T = 8192;
constexpr int SEQ = 4096;
constexpr int D = 2048, DS = 1024, DG = 1024, NIN = 3072, FF = 5632, PLE = 256;
constexpr int NG = 64, NP = 64, NH = 16;
constexpr int LC = 16;
constexpr int NCH = T / LC;
constexpr int KC = LC * NH + 2 * NP;
constexpr int KA = LC * NH;
constexpr float EPS = 1e-6f;

constexpr size_t MiB = 1u << 20;
constexpr size_t WS_CTL = 0, CTL_ZERO_BYTES = 64 * 1024;
constexpr size_t WS_WFFI = 1 * MiB;
constexpr size_t WS_WFFO = WS_WFFI + 44 * MiB;
constexpr size_t WS_WG   = WS_WFFO + 22 * MiB;
constexpr size_t WS_WPLE = WS_WG + 8 * MiB;
constexpr size_t WS_XB   = WS_WPLE + 1 * MiB;
constexpr size_t WS_PROJ = WS_XB + 32 * MiB;
constexpr size_t WS_SSQA = WS_PROJ + 32 * MiB;
constexpr size_t WS_SSQB = WS_SSQA + 1 * MiB;
constexpr size_t WS_SSQ1 = WS_SSQB + 1 * MiB;
constexpr size_t WS_SSQ2 = WS_SSQ1 + 1 * MiB;
constexpr size_t WS_SSQ3 = WS_SSQ2 + 1 * MiB;
constexpr size_t WS_LNST = WS_SSQ3 + 1 * MiB;
constexpr size_t WS_R0   = WS_LNST + 1 * MiB;
constexpr size_t WS_EARLY = WS_R0 + 1 * MiB;
constexpr size_t WS_WIN  = WS_EARLY;
constexpr size_t WS_WGLU = WS_WIN + 12 * MiB;
constexpr size_t WS_WOUT = WS_WGLU + 2 * MiB;
constexpr size_t WS_TF   = WS_WOUT + 8 * MiB;
constexpr size_t WS_E    = WS_TF + 12 * MiB;
constexpr size_t WS_A16  = WS_E + 5 * MiB;
constexpr size_t WS_AC   = WS_A16 + 1 * MiB;
constexpr size_t WS_GU   = WS_AC + 24 * MiB;
constexpr size_t WS_GV   = WS_GU + 16 * MiB;
constexpr size_t WS_SLOC = WS_GV + 16 * MiB;
constexpr size_t WS_YAPRE = WS_SLOC + 16 * MiB;
constexpr size_t WS_Y    = WS_YAPRE + 16 * MiB;
constexpr size_t WS_PB   = WS_Y + 32 * MiB;
constexpr size_t WS_EARLY_END = WS_PB + 4 * MiB;
constexpr size_t WS_H    = WS_EARLY;
constexpr size_t WS_END  = (WS_EARLY_END > WS_H + 88 * MiB) ? WS_EARLY_END : WS_H + 88 * MiB;

constexpr int CW_BAR = 4096;

constexpr int RING_BYTES = 131072;
constexpr int LDSCTL_OFF = RING_BYTES, MISC_OFF = LDSCTL_OFF + 320;
constexpr int LDS_BYTES = 147456;
constexpr int NWAVES = 8;

#define RLX_AGENT __ATOMIC_RELAXED, __HIP_MEMORY_SCOPE_AGENT
#define LDS_WAIT() asm volatile("s_waitcnt lgkmcnt(0)" ::: "memory")
#define VM_WAIT() asm volatile("s_waitcnt vmcnt(0)" ::: "memory")
__device__ __forceinline__ unsigned cvt_pk_bf16(float lo, float hi) { unsigned r; asm volatile("v_cvt_pk_bf16_f32 %0, %1, %2" : "=v"(r) : "v"(lo), "v"(hi)); return r; }
__device__ __forceinline__ float bf_lo(unsigned w) { return __uint_as_float(w << 16); }
__device__ __forceinline__ float bf_hi(unsigned w) { return __uint_as_float(w & 0xffff0000u); }
__device__ __forceinline__ float fast_sigmoid(float y) { return __builtin_amdgcn_rcpf(1.0f + __builtin_amdgcn_exp2f(-1.4426950408889634f * y)); }
__device__ __forceinline__ float gelu_tanh(float x) { const float y = 1.5957691216057308f * (x + 0.044715f * x * x * x); return x * fast_sigmoid(y); }
__device__ __forceinline__ float silu(float x) { return x * fast_sigmoid(x); }
__device__ __forceinline__ float wave_sum(float v) {
#pragma unroll
    for (int o = 1; o < 64; o <<= 1) v += __shfl_xor(v, o);
    return v;
}

namespace pg8 {
constexpr int BM = 256, BK = 64, HALF = 128, HTB = HALF * BK * 2, NXCD = 8, WGM = 8;
__host__ __device__ __forceinline__ int lds_byte(int r, int c) { const int st = (r >> 4) * 2 + (c >> 5), rr = r & 15, cc = c & 31, ob = rr * 64 + cc * 2; return st * 1024 + (ob ^ (((ob >> 9) & 1) << 5)); }
__host__ __device__ __forceinline__ void stage_rc(int b, int& R, int& C) { const int st = b / 1024, sb = b % 1024, swz = sb ^ (((sb >> 9) & 1) << 5); R = (st >> 1) * 16 + swz / 64; C = (st & 1) * 32 + (swz % 64) / 2; }
__host__ __device__ __forceinline__ int perm32(int rho) { const int n = rho >> 4, i = rho & 15; return 8 * (i >> 2) + 4 * n + (i & 3); }

struct Unit { const char* A; const char* B; int pm, pn, g; };

struct SchedTiles {
    const char* A; const char* B; size_t tstepA, tstepB; int nM, nN, nwg, G, c;
    __device__ __forceinline__ void init(const void* A_, const void* B_, int M, int N, int lda, int ldb, int G_, int c_) {
        A = (const char*)A_; B = (const char*)B_; tstepA = (size_t)BM * lda * 2; tstepB = (size_t)BM * ldb * 2; nM = M / BM; nN = N / BM; nwg = nM * nN; G = G_; c = c_; }
    __device__ __forceinline__ bool next(int i, Unit& u) const {
        const int L = i * G + c; if (L >= nwg) return false;
        int wgid = L; { const int q = nwg / NXCD, r = nwg % NXCD, xcd = wgid % NXCD, off = wgid / NXCD; wgid = (xcd < r ? xcd * (q + 1) : r * (q + 1) + (xcd - r) * q) + off; }
        const int nig = WGM * nN, gid = wgid / nig, fm = gid * WGM, gsz = (nM - fm) < WGM ? (nM - fm) : WGM;
        u.pm = fm + ((wgid % nig) % gsz); u.pn = (wgid % nig) / gsz; u.g = 0;
        u.A = A + (size_t)u.pm * tstepA; u.B = B + (size_t)u.pn * tstepB; return true;
    }
};
struct SchedOne { Unit u; __device__ __forceinline__ bool next(int i, Unit& o) const { if (i != 0) return false; o = u; return true; } };

template <class Epi, class Sched, bool ALIGN_EPI>
__device__ __forceinline__ void gemm_phase(LAS unsigned char* lds, const int K, const int lda, const int ldb, const Sched& S, const Epi& E, int tid) {
    asm volatile("" : "+v"(tid));
    const int wid = __builtin_amdgcn_readfirstlane(tid >> 6), lane = tid & 63, wr = wid >> 2, wc = wid & 3, fr = lane & 15, fq = lane >> 4;
    const int nt = K / BK;
    unsigned voffA[2], voffB[2];
#pragma unroll
    for (int i = 0; i < 2; ++i) { int R, C; stage_rc(tid * 16 + i * 8192, R, C); const int Rb = (R & ~31) + perm32(R & 31);
        voffA[i] = (unsigned)(R * lda + C) * 2u; voffB[i] = (unsigned)(Rb * ldb + C) * 2u; }
    const size_t kstep = (size_t)(BK * 2);
    const size_t hstepA = (size_t)HALF * lda * 2, hstepB = (size_t)HALF * ldb * 2;
    const unsigned ldsw = (unsigned)wid * 1024u;
    const int aoff = lds_byte(wr * 64 + fr, fq * 8), boff = lds_byte(wc * 32 + fr, fq * 8);
#define PG8_SA(b, h) (((b) * 2 + (h)) * HTB)
#define PG8_SB(b, h) ((4 + (b) * 2 + (h)) * HTB)
#define PG8_STAGE(bufoff, gbase, voff) do { _Pragma("unroll") for (int _i = 0; _i < 2; ++_i) \
        __builtin_amdgcn_global_load_lds((const unsigned*)((const char*)(gbase) + (voff)[_i]), (LAS unsigned*)(lds + (bufoff) + ldsw + _i * 8192), 16, 0, 0); } while (0)
#define PG8_LDA(dst, b, h) do { _Pragma("unroll") for (int m = 0; m < 4; ++m) _Pragma("unroll") for (int k = 0; k < 2; ++k) dst[m][k] = *(const LAS bf16x8*)(lds + PG8_SA(b, h) + aoff + m * 2048 + k * 1024); } while (0)
#define PG8_LDB(dst, b, h) do { _Pragma("unroll") for (int n = 0; n < 2; ++n) _Pragma("unroll") for (int k = 0; k < 2; ++k) dst[n][k] = *(const LAS bf16x8*)(lds + PG8_SB(b, h) + boff + n * 2048 + k * 1024); } while (0)
#define PG8_MMA(ai, bj, At, Bt) do { __builtin_amdgcn_s_setprio(1); _Pragma("unroll") for (int m = 0; m < 4; ++m) _Pragma("unroll") for (int n = 0; n < 2; ++n) _Pragma("unroll") for (int k = 0; k < 2; ++k) \
        acc[ai][bj][m][n] = __builtin_amdgcn_mfma_f32_16x16x32_bf16(Bt[n][k], At[m][k], acc[ai][bj][m][n], 0, 0, 0); __builtin_amdgcn_s_setprio(0); } while (0)
#define PG8_WAIT_V(n) asm volatile("s_waitcnt vmcnt(" #n ")" ::: "memory")
#define PG8_WAIT_L(n) asm volatile("s_waitcnt lgkmcnt(" #n ")" ::: "memory")
#define PG8_BAR __builtin_amdgcn_s_barrier()
#define PG8_SCHED __builtin_amdgcn_sched_barrier(0)
    Unit cur, nxt; int ui = 0;
    if (!S.next(0, cur)) return;
    f32x4 acc[2][2][4][2];
#pragma unroll
    for (int a = 0; a < 2; ++a)
#pragma unroll
        for (int b = 0; b < 2; ++b)
#pragma unroll
            for (int m = 0; m < 4; ++m)
#pragma unroll
                for (int n = 0; n < 2; ++n) acc[a][b][m][n] = (f32x4){0.f, 0.f, 0.f, 0.f};
    bf16x8 At[4][2], B0[2][2], B1[2][2];
    const char* cA = cur.A; const char* cB = cur.B;
    PG8_STAGE(PG8_SB(0, 0), cB, voffB); PG8_STAGE(PG8_SB(0, 1), cB + hstepB, voffB); PG8_STAGE(PG8_SA(0, 0), cA, voffA); PG8_STAGE(PG8_SA(0, 1), cA + hstepA, voffA);
    if (wr == 1) PG8_BAR;
    PG8_WAIT_V(2); PG8_BAR;
    PG8_STAGE(PG8_SB(1, 0), cB + kstep, voffB); PG8_STAGE(PG8_SA(1, 0), cA + kstep, voffA); PG8_STAGE(PG8_SB(1, 1), cB + hstepB + kstep, voffB);
    PG8_WAIT_V(6); PG8_BAR;
    for (;;) {
        const bool has_next = S.next(ui + 1, nxt);
        const char* nA = has_next ? nxt.A : cA; const char* nB = has_next ? nxt.B : cB;
        for (int t = 0; t < nt; t += 2) {
            const bool last = (t == nt - 2);
            const char* a1 = cA + (size_t)(t + 1) * kstep;
            const char* a2 = last ? nA : cA + (size_t)(t + 2) * kstep; const char* b2 = last ? nB : cB + (size_t)(t + 2) * kstep;
            const char* a3 = a2 + kstep; const char* b3 = b2 + kstep;
            if constexpr (Epi::MID) { if (t == (nt >> 1)) E.mid(acc, cur, wr, wc, fr, fq); }
            PG8_LDB(B0, 0, 0); PG8_LDB(B1, 0, 1); PG8_SCHED; PG8_LDA(At, 0, 0); PG8_STAGE(PG8_SA(1, 1), a1 + hstepA, voffA);
            PG8_WAIT_V(8); PG8_WAIT_L(0); PG8_BAR; PG8_MMA(0, 0, At, B0); PG8_MMA(0, 1, At, B1); PG8_BAR; PG8_SCHED;
            PG8_LDA(At, 0, 1); PG8_STAGE(PG8_SB(0, 0), b2, voffB); PG8_STAGE(PG8_SB(0, 1), b2 + hstepB, voffB); PG8_STAGE(PG8_SA(0, 0), a2, voffA);
            PG8_WAIT_V(8); PG8_WAIT_L(0); PG8_BAR; PG8_MMA(1, 0, At, B0); PG8_MMA(1, 1, At, B1); PG8_BAR; PG8_SCHED;
            PG8_LDB(B0, 1, 0); PG8_LDB(B1, 1, 1); PG8_SCHED; PG8_LDA(At, 1, 0); PG8_STAGE(PG8_SA(0, 1), a2 + hstepA, voffA);
            PG8_WAIT_V(8); PG8_WAIT_L(0); PG8_BAR; PG8_MMA(0, 0, At, B0); PG8_MMA(0, 1, At, B1); PG8_BAR; PG8_SCHED;
            PG8_LDA(At, 1, 1); PG8_STAGE(PG8_SB(1, 0), b3, voffB); PG8_STAGE(PG8_SB(1, 1), b3 + hstepB, voffB); PG8_STAGE(PG8_SA(1, 0), a3, voffA);
            PG8_WAIT_V(8); PG8_WAIT_L(0); PG8_BAR; PG8_MMA(1, 0, At, B0); PG8_MMA(1, 1, At, B1); PG8_BAR; PG8_SCHED;
        }
        if constexpr (ALIGN_EPI) { if (wr == 0) PG8_BAR; }
        E(acc, cur, wr, wc, fr, fq);
        if (!has_next) break;
#pragma unroll
        for (int a = 0; a < 2; ++a)
#pragma unroll
            for (int b = 0; b < 2; ++b)
#pragma unroll
                for (int m = 0; m < 4; ++m)
#pragma unroll
                    for (int n = 0; n < 2; ++n) acc[a][b][m][n] = (f32x4){0.f, 0.f, 0.f, 0.f};
        cur = nxt; cA = nA; cB = nB; ++ui;
        if constexpr (ALIGN_EPI) { if (wr == 1) PG8_BAR; }
    }
    PG8_WAIT_V(0);
    if constexpr (!ALIGN_EPI) { if (wr == 0) PG8_BAR; }
    PG8_BAR;
#undef PG8_SA
#undef PG8_SB
#undef PG8_STAGE
#undef PG8_LDA
#undef PG8_LDB
#undef PG8_MMA
#undef PG8_WAIT_V
#undef PG8_WAIT_L
#undef PG8_BAR
#undef PG8_SCHED
}
}
using pg8::Unit;

#define EPI_ROWS(ai, m) _Pragma("unroll") for (int ai = 0; ai < 2; ++ai) _Pragma("unroll") for (int m = 0; m < 4; ++m)
typedef f32x4 acc_t[2][2][4][2];
#define EPI_FENCE(m) do { if ((m) & 1) asm volatile("" ::: "memory"); } while (0)

__device__ __forceinline__ u32x4 pack8(f32x4 v0, f32x4 v1) { u32x4 w; w.x = cvt_pk_bf16(v0[0], v0[1]); w.y = cvt_pk_bf16(v0[2], v0[3]); w.z = cvt_pk_bf16(v1[0], v1[1]); w.w = cvt_pk_bf16(v1[2], v1[3]); return w; }
__device__ __forceinline__ float sumsq8(f32x4 a, f32x4 b) { return ((a[0] * a[0] + a[1] * a[1]) + (a[2] * a[2] + a[3] * a[3])) + ((b[0] * b[0] + b[1] * b[1]) + (b[2] * b[2] + b[3] * b[3])); }
__device__ __forceinline__ float sum8(f32x4 a, f32x4 b) { return ((a[0] + a[1]) + (a[2] + a[3])) + ((b[0] + b[1]) + (b[2] + b[3])); }
__device__ __forceinline__ void unpack8(u32x4 w, f32x4& a, f32x4& b) { a = (f32x4){bf_lo(w.x), bf_hi(w.x), bf_lo(w.y), bf_hi(w.y)}; b = (f32x4){bf_lo(w.z), bf_hi(w.z), bf_lo(w.w), bf_hi(w.w)}; }
template <int NPART> __device__ __forceinline__ float row_partials(const float* base, int row, int fq) {
    float s;
    if constexpr (NPART == 32) { const f32x4 a = *(const f32x4*)(base + (size_t)row * 32 + 8 * fq), b = *(const f32x4*)(base + (size_t)row * 32 + 8 * fq + 4); s = sum8(a, b); }
    else if constexpr (NPART == 16) { const f32x4 a = *(const f32x4*)(base + (size_t)row * 16 + 4 * fq); s = (a[0] + a[1]) + (a[2] + a[3]); }
    else { const f32x2 a = *(const f32x2*)(base + (size_t)row * 8 + 2 * fq); s = a[0] + a[1]; }
    s += __shfl_xor(s, 16); s += __shfl_xor(s, 32); return s;
}

struct EpiIn {
    static constexpr bool MID = false;
    const float* r0; bf16* AC; bf16* gu; bf16* gv; float* lnst;
    __device__ __forceinline__ void mid(acc_t&, const Unit&, int, int, int, int) const {}
    __device__ __forceinline__ void operator()(const acc_t& acc, const Unit& u, int wr, int wc, int fr, int fq) const {
        asm volatile("" : "+v"(fr), "+v"(fq));
        const int sect = u.pn >> 2;
        EPI_ROWS(ai, m) {
            const int row = u.pm * 256 + ai * 128 + wr * 64 + m * 16 + fr; const float rs = r0[row];
            float s1 = 0.f, s2 = 0.f;
#pragma unroll
            for (int bj = 0; bj < 2; ++bj) {
                const int col = u.pn * 256 + bj * 128 + wc * 32 + 8 * fq;
                f32x4 v0 = acc[ai][bj][m][0] * rs, v1 = acc[ai][bj][m][1] * rs;
                if (sect == 0) {
                    const int g = col >> 4, hi0 = col & 15, chunk = row >> 4, i = row & 15;
                    *(u32x4*)(AC + ((size_t)(g * NCH + chunk) * KC + i * 16 + hi0)) = pack8(v0, v1);
                } else {
#pragma unroll
                    for (int j = 0; j < 4; ++j) { v0[j] = gelu_tanh(v0[j]); v1[j] = gelu_tanh(v1[j]); }
                    if (sect == 1) *(u32x4*)(gu + (size_t)row * DG + (col - 1024)) = pack8(v0, v1);
                    else { *(u32x4*)(gv + (size_t)row * DG + (col - 2048)) = pack8(v0, v1); s1 += sum8(v0, v1); s2 += sumsq8(v0, v1); }
                }
            }
            if (sect == 2) {
                s1 += __shfl_xor(s1, 16); s1 += __shfl_xor(s1, 32); s2 += __shfl_xor(s2, 16); s2 += __shfl_xor(s2, 32);
                if (fq == 0) *(f32x2*)(lnst + ((size_t)row * 16 + (u.pn - 8) * 4 + wc) * 2) = (f32x2){s1, s2};
            }
        }
    }
};
struct EpiSloc {
    static constexpr bool MID = false;
    float* sloc;
    __device__ __forceinline__ void mid(acc_t&, const Unit&, int, int, int, int) const {}
    __device__ __forceinline__ void operator()(const acc_t& acc, const Unit& u, int wr, int wc, int fr, int fq) const {
        asm volatile("" : "+v"(fr), "+v"(fq));
        EPI_ROWS(ai, m) {
            const int row = u.pm * 256 + ai * 128 + wr * 64 + m * 16 + fr;
            float* o = sloc + ((size_t)(u.g * NCH + row) * 128 + wc * 32 + 8 * fq);
            *(f32x4*)o = acc[ai][0][m][0]; *(f32x4*)(o + 4) = acc[ai][0][m][1];
        }
    }
};
struct EpiS5Out {
    static constexpr bool MID = false;
    const bf16* AC; const float* dvec; bf16* yapre;
    __device__ __forceinline__ void mid(acc_t&, const Unit&, int, int, int, int) const {}
    __device__ __forceinline__ void operator()(const acc_t& acc, const Unit& u, int wr, int wc, int fr, int fq) const {
        asm volatile("" : "+v"(fr), "+v"(fq));
        const int ho0 = 8 * (fq & 1);
        const f32x4 d0 = *(const f32x4*)(dvec + u.g * 16 + ho0), d1 = *(const f32x4*)(dvec + u.g * 16 + ho0 + 4);
        EPI_ROWS(ai, m) {
            const int chunk = u.pm * 256 + ai * 128 + wr * 64 + m * 16 + fr;
#pragma unroll
            for (int bj = 0; bj < 2; ++bj) {
                const int n0 = bj * 128 + wc * 32 + 8 * fq, j = n0 >> 4;
                const u32x4 uw = *(const u32x4*)(AC + ((size_t)(u.g * NCH + chunk) * KC + j * 16 + ho0));
                f32x4 u0, u1; unpack8(uw, u0, u1);
                f32x4 v0 = acc[ai][bj][m][0] + d0 * u0, v1 = acc[ai][bj][m][1] + d1 * u1;
#pragma unroll
                for (int q = 0; q < 4; ++q) { v0[q] = gelu_tanh(v0[q]); v1[q] = gelu_tanh(v1[q]); }
                const int token = chunk * LC + j;
                *(u32x4*)(yapre + (size_t)token * DS + u.g * 16 + ho0) = pack8(v0, v1);
            }
            EPI_FENCE(m);
        }
    }
};
struct EpiGlu {
    static constexpr bool MID = false;
    const bf16* yapre; const float* bias; bf16* Y; float* ssqa;
    __device__ __forceinline__ void mid(acc_t&, const Unit&, int, int, int, int) const {}
    __device__ __forceinline__ void operator()(const acc_t& acc, const Unit& u, int wr, int wc, int fr, int fq) const {
        asm volatile("" : "+v"(fr), "+v"(fq));
        f32x4 bv[2][2];
#pragma unroll
        for (int bj = 0; bj < 2; ++bj) { const int col = u.pn * 256 + bj * 128 + wc * 32 + 8 * fq; bv[bj][0] = *(const f32x4*)(bias + col); bv[bj][1] = *(const f32x4*)(bias + col + 4); }
        EPI_ROWS(ai, m) {
            const int row = u.pm * 256 + ai * 128 + wr * 64 + m * 16 + fr; float ss = 0.f;
#pragma unroll
            for (int bj = 0; bj < 2; ++bj) {
                const int col = u.pn * 256 + bj * 128 + wc * 32 + 8 * fq;
                f32x4 y0, y1; unpack8(*(const u32x4*)(yapre + (size_t)row * DS + col), y0, y1);
                f32x4 v0 = acc[ai][bj][m][0] + bv[bj][0], v1 = acc[ai][bj][m][1] + bv[bj][1];
#pragma unroll
                for (int q = 0; q < 4; ++q) { v0[q] = y0[q] * fast_sigmoid(v0[q]); v1[q] = y1[q] * fast_sigmoid(v1[q]); }
                ss += sumsq8(v0, v1);
                *(u32x4*)(Y + (size_t)row * D + col) = pack8(v0, v1);
            }
            ss += __shfl_xor(ss, 16); ss += __shfl_xor(ss, 32);
            if (fq == 0) ssqa[(size_t)row * 16 + u.pn * 4 + wc] = ss;
            EPI_FENCE(m);
        }
    }
};
struct EpiProj {
    static constexpr bool MID = false;
    bf16* proj;
    __device__ __forceinline__ void mid(acc_t&, const Unit&, int, int, int, int) const {}
    __device__ __forceinline__ void operator()(const acc_t& acc, const Unit& u, int wr, int wc, int fr, int fq) const {
        asm volatile("" : "+v"(fr), "+v"(fq));
        EPI_ROWS(ai, m) {
            const int row = u.pm * 256 + ai * 128 + wr * 64 + m * 16 + fr;
#pragma unroll
            for (int bj = 0; bj < 2; ++bj) { const int col = u.pn * 256 + bj * 128 + wc * 32 + 8 * fq; *(u32x4*)(proj + (size_t)row * D + col) = pack8(acc[ai][bj][m][0], acc[ai][bj][m][1]); }
        }
    }
};
struct EpiOut {
    static constexpr bool MID = true;
    const float* ssqa; const float* ssqb; const float* x; float* xo; bf16* xb; float* ssq1;
    __device__ __forceinline__ void mid(acc_t& acc, const Unit& u, int wr, int wc, int fr, int fq) const {
        asm volatile("" : "+v"(fr), "+v"(fq));
        EPI_ROWS(ai, m) {
            const int row = u.pm * 256 + ai * 128 + wr * 64 + m * 16 + fr;
            const float sa = row_partials<16>(ssqa, row, fq), sb = row_partials<8>(ssqb, row, fq);
            const float ratio = sqrtf((sb * (1.0f / 1024.0f) + EPS) / (sa * (1.0f / 1024.0f) + EPS));
#pragma unroll
            for (int bj = 0; bj < 2; ++bj) { acc[ai][bj][m][0] *= ratio; acc[ai][bj][m][1] *= ratio; }
            EPI_FENCE(m);
        }
    }
    __device__ __forceinline__ void operator()(const acc_t& acc, const Unit& u, int wr, int wc, int fr, int fq) const {
        asm volatile("" : "+v"(fr), "+v"(fq));
        EPI_ROWS(ai, m) {
            const int row = u.pm * 256 + ai * 128 + wr * 64 + m * 16 + fr;
            const float sb = row_partials<8>(ssqb, row, fq); const float rb = 1.0f / sqrtf(sb * (1.0f / 1024.0f) + EPS); float ss = 0.f;
#pragma unroll
            for (int bj = 0; bj < 2; ++bj) {
                const size_t off = (size_t)row * D + u.pn * 256 + bj * 128 + wc * 32 + 8 * fq;
                const f32x4 v0 = *(const f32x4*)(x + off) + acc[ai][bj][m][0] * rb, v1 = *(const f32x4*)(x + off + 4) + acc[ai][bj][m][1] * rb;
                *(f32x4*)(xo + off) = v0; *(f32x4*)(xo + off + 4) = v1; *(u32x4*)(xb + off) = pack8(v0, v1); ss += sumsq8(v0, v1);
            }
            ss += __shfl_xor(ss, 16); ss += __shfl_xor(ss, 32);
            if (fq == 0) ssq1[(size_t)row * 32 + u.pn * 4 + wc] = ss;
            EPI_FENCE(m);
        }
    }
};
struct EpiFfnIn {
    static constexpr bool MID = false;
    const float* ssq1; bf16* h;
    __device__ __forceinline__ void mid(acc_t&, const Unit&, int, int, int, int) const {}
    __device__ __forceinline__ void operator()(const acc_t& acc, const Unit& u, int wr, int wc, int fr, int fq) const {
        asm volatile("" : "+v"(fr), "+v"(fq));
        EPI_ROWS(ai, m) {
            const int row = u.pm * 256 + ai * 128 + wr * 64 + m * 16 + fr;
            const float r1 = 1.0f / sqrtf(row_partials<32>(ssq1, row, fq) * (1.0f / 2048.0f) + EPS);
            f32x4 g0 = acc[ai][0][m][0] * r1, g1 = acc[ai][0][m][1] * r1; const f32x4 u0 = acc[ai][1][m][0] * r1, u1 = acc[ai][1][m][1] * r1;
#pragma unroll
            for (int q = 0; q < 4; ++q) { g0[q] = silu(g0[q]) * u0[q]; g1[q] = silu(g1[q]) * u1[q]; }
            *(u32x4*)(h + (size_t)row * FF + u.pn * 128 + wc * 32 + 8 * fq) = pack8(g0, g1);
            EPI_FENCE(m);
        }
    }
};
struct EpiFfnOut {
    static constexpr bool MID = false;
    float* xo; bf16* xb; float* ssq2;
    __device__ __forceinline__ void mid(acc_t&, const Unit&, int, int, int, int) const {}
    __device__ __forceinline__ void operator()(const acc_t& acc, const Unit& u, int wr, int wc, int fr, int fq) const {
        asm volatile("" : "+v"(fr), "+v"(fq));
        EPI_ROWS(ai, m) {
            const int row = u.pm * 256 + ai * 128 + wr * 64 + m * 16 + fr; float ss = 0.f;
#pragma unroll
            for (int bj = 0; bj < 2; ++bj) {
                const size_t off = (size_t)row * D + u.pn * 256 + bj * 128 + wc * 32 + 8 * fq;
                const f32x4 v0 = *(const f32x4*)(xo + off) + acc[ai][bj][m][0], v1 = *(const f32x4*)(xo + off + 4) + acc[ai][bj][m][1];
                *(f32x4*)(xo + off) = v0; *(f32x4*)(xo + off + 4) = v1; *(u32x4*)(xb + off) = pack8(v0, v1); ss += sumsq8(v0, v1);
            }
            ss += __shfl_xor(ss, 16); ss += __shfl_xor(ss, 32);
            if (fq == 0) ssq2[(size_t)row * 32 + u.pn * 4 + wc] = ss;
            EPI_FENCE(m);
        }
    }
};
struct EpiPle {
    static constexpr bool MID = false;
    const float* ssq2; const float* bias; const bf16* proj; float* xo; float* ssq3;
    __device__ __forceinline__ void mid(acc_t&, const Unit&, int, int, int, int) const {}
    __device__ __forceinline__ void operator()(const acc_t& acc, const Unit& u, int wr, int wc, int fr, int fq) const {
        asm volatile("" : "+v"(fr), "+v"(fq));
        f32x4 bv[2][2];
#pragma unroll
        for (int bj = 0; bj < 2; ++bj) { const int col = u.pn * 256 + bj * 128 + wc * 32 + 8 * fq; bv[bj][0] = *(const f32x4*)(bias + col); bv[bj][1] = *(const f32x4*)(bias + col + 4); }
        EPI_ROWS(ai, m) {
            const int row = u.pm * 256 + ai * 128 + wr * 64 + m * 16 + fr;
            const float r2 = 1.0f / sqrtf(row_partials<32>(ssq2, row, fq) * (1.0f / 2048.0f) + EPS); float ss = 0.f;
#pragma unroll
            for (int bj = 0; bj < 2; ++bj) {
                const size_t off = (size_t)row * D + u.pn * 256 + bj * 128 + wc * 32 + 8 * fq;
                f32x4 p0, p1; unpack8(*(const u32x4*)(proj + off), p0, p1);
                f32x4 v0 = acc[ai][bj][m][0] * r2 + bv[bj][0], v1 = acc[ai][bj][m][1] * r2 + bv[bj][1];
                const f32x4 x0 = *(const f32x4*)(xo + off), x1 = *(const f32x4*)(xo + off + 4);
#pragma unroll
                for (int q = 0; q < 4; ++q) { v0[q] = x0[q] + fast_sigmoid(v0[q]) * p0[q]; v1[q] = x1[q] + fast_sigmoid(v1[q]) * p1[q]; }
                *(f32x4*)(xo + off) = v0; *(f32x4*)(xo + off + 4) = v1; ss += sumsq8(v0, v1);
            }
            ss += __shfl_xor(ss, 16); ss += __shfl_xor(ss, 32);
            if (fq == 0) ssq3[(size_t)row * 32 + u.pn * 4 + wc] = ss;
            EPI_FENCE(m);
        }
    }
};

#define XB_TMO      128
#define XB_XCNT(j)  (256  + 64 * (j))
#define XB_XSUB(j)  (1280 + 64 * (j))
#define XB_XGEN(j)  (2304 + 64 * (j))
#define XB_TOP      3328
#define XB_TOPGEN   3392
#define XCD_BAR_WORDS 3456
#define XB_SPIN_CAP (1u << 18)
__device__ __forceinline__ unsigned xb_ld(unsigned* p)              { return __hip_atomic_load(p, __ATOMIC_RELAXED, __HIP_MEMORY_SCOPE_AGENT); }
__device__ __forceinline__ unsigned xb_add(unsigned* p, unsigned v) { return __hip_atomic_fetch_add(p, v, __ATOMIC_RELAXED, __HIP_MEMORY_SCOPE_AGENT); }
__device__ __forceinline__ unsigned xb_xcc_id() { return (unsigned)__builtin_amdgcn_s_getreg((3 << 11) | 20) & 0xFu; }
#define XB_SPIN(cond, bar) do { unsigned _sp = 0; while (cond) { __builtin_amdgcn_s_sleep(1); \
    if ((++_sp & 255u) == 0u) { if (xb_ld(&(bar)[XB_TMO])) break; if (_sp > XB_SPIN_CAP) { atomicAdd(&(bar)[XB_TMO], 1u); break; } } } } while (0)
struct XcdBarrier { unsigned* bar; unsigned x; volatile LAS unsigned* st; };
__device__ __forceinline__ XcdBarrier xcd_barrier_post(unsigned* bar, volatile LAS unsigned* st) {
    XcdBarrier b; b.bar = bar; b.x = xb_xcc_id(); b.st = st;
    if (threadIdx.x == 0) (void)xb_add(&bar[XB_XCNT(b.x)], 1u);
    return b;
}
__device__ __forceinline__ void xcd_barrier_complete(unsigned* bar, unsigned x, unsigned& nloc, unsigned& nx) {
    const unsigned G = gridDim.x * gridDim.y * gridDim.z;
    unsigned sum, cnt, mine, sp = 0u;
    for (;;) {
        sum = 0u; cnt = 0u; mine = 0u;
#pragma unroll
        for (unsigned j = 0; j < 16; ++j) { const unsigned c = xb_ld(&bar[XB_XCNT(j)]); sum += c; cnt += (c > 0u) ? 1u : 0u; mine = (j == x) ? c : mine; }
        if (sum == G) break;
        __builtin_amdgcn_s_sleep(1);
        if ((++sp & 255u) == 0u) { if (xb_ld(&bar[XB_TMO])) break; if (sp > XB_SPIN_CAP) { atomicAdd(&bar[XB_TMO], 1u); break; } }
    }
    nloc = mine > 0u ? mine : 1u; nx = cnt > 0u ? cnt : 1u;
}
__device__ __forceinline__ void xcd_barrier(const XcdBarrier& b) {
    asm volatile("s_waitcnt vmcnt(0)" ::: "memory");
    __syncthreads();
    if (threadIdx.x == 0) {
        unsigned* bar = b.bar;
        __builtin_amdgcn_s_waitcnt(0);
        unsigned nloc = b.st[0], nx = b.st[1];
        if (nloc == 0u) { xcd_barrier_complete(bar, b.x, nloc, nx); b.st[0] = nloc; b.st[1] = nx; }
        const unsigned old = xb_add(&bar[XB_XSUB(b.x)], 1u);
        const unsigned gen = old / nloc;
        if (old + 1u == (gen + 1u) * nloc) {
            __builtin_amdgcn_fence(__ATOMIC_RELEASE, "agent");
            asm volatile("s_waitcnt vmcnt(0)" ::: "memory");
            const unsigned og = xb_add(&bar[XB_TOP], 1u);
            const unsigned tg = og / nx;
            if (og + 1u == (tg + 1u) * nx) xb_add(&bar[XB_TOPGEN], 1u);
            else XB_SPIN(xb_ld(&bar[XB_TOPGEN]) == tg, bar);
            __builtin_amdgcn_fence(__ATOMIC_ACQUIRE, "agent");
            xb_add(&bar[XB_XGEN(b.x)], 1u);
            asm volatile("s_waitcnt vmcnt(0)" ::: "memory");
        } else {
            XB_SPIN(xb_ld(&bar[XB_XGEN(b.x)]) == gen, bar);
            __builtin_amdgcn_fence(__ATOMIC_ACQUIRE, "agent");
            asm volatile("s_waitcnt vmcnt(0)" ::: "memory");
        }
    }
    __syncthreads();
}

struct Args { const float* in[29]; float* out; unsigned char* ws; int ph_lo, ph_hi, li, pad; };
enum In { I_X = 0, I_P, I_NMIXG, I_WIN, I_LRE, I_LIM, I_LSTEP, I_BRE, I_BIM, I_CRE, I_CIM, I_SD, I_GLUW, I_GLUB, I_LNG, I_LNB, I_SGUW, I_SGUB,
          I_ONSSM, I_ONSGU, I_WOUT, I_NFFNG, I_WFFI, I_WFFO, I_NPLEG, I_WG, I_BG, I_WPLE, I_FNG };

__device__ __forceinline__ void p0_transpose_item(const float* W, int N, const float* gain, bf16* WT, int ldt, int dst_row0, int k0, int n0, LAS float* scr, int lane) {
    float v[32];
    const float* src = W + (size_t)(k0 + (lane >> 5)) * N + n0 + (lane & 31);
#pragma unroll
    for (int i = 0; i < 32; ++i) v[i] = src[(size_t)(2 * i) * N];
    if (gain) {
#pragma unroll
        for (int i = 0; i < 32; ++i) v[i] *= gain[k0 + 2 * i + (lane >> 5)];
    }
#pragma unroll
    for (int i = 0; i < 32; ++i) scr[(2 * i + (lane >> 5)) * 33 + (lane & 31)] = v[i];
    LDS_WAIT(); asm volatile("" ::: "memory");
    const int c = lane & 7;
#pragma unroll
    for (int j = 0; j < 4; ++j) { const int n = (lane >> 3) + 8 * j; const LAS float* s = scr + (8 * c) * 33 + n;
        u32x4 o; o.x = cvt_pk_bf16(s[0 * 33], s[1 * 33]); o.y = cvt_pk_bf16(s[2 * 33], s[3 * 33]); o.z = cvt_pk_bf16(s[4 * 33], s[5 * 33]); o.w = cvt_pk_bf16(s[6 * 33], s[7 * 33]);
        *(u32x4*)(WT + (size_t)(dst_row0 + n) * ldt + k0 + 8 * c) = o; }
    LDS_WAIT(); asm volatile("" ::: "memory");
}
template <int MODE>
__device__ __forceinline__ void p0_transpose(const float* W, int K, int N, const float* gain, const float* gain2, bf16* WT, LAS float* scr, int gw, int ngw, int lane) {
    const int nblk = N / 32, nitems = (K / 64) * nblk;
    for (int it = gw; it < nitems; it += ngw) {
        const int kb = it / nblk, nb = it % nblk, k0 = 64 * kb, n0 = 32 * nb;
        int dst = n0;
        if (MODE == 1) { const int half = (n0 >= FF) ? 1 : 0, j = n0 - half * FF; dst = 256 * (j >> 7) + 128 * half + (j & 127); }
        const float* g = gain; if (gain2 && k0 >= 1024) g = gain2 - 1024;
        p0_transpose_item(W, N, g, WT, K, dst, k0, n0, scr, lane);
    }
}
__device__ __forceinline__ void p0_s5_tables(const Args& a, int g, LAS float* L, int tid) {
    LAS float* apow = L;
    LAS float* Bb = L + 2176;
    LAS float* Cc = L + 2176 + 2048;
    LAS float* Kk = L + 2176 + 4096;
    bf16* TF = (bf16*)(a.ws + WS_TF) + (size_t)g * 256 * KC;
    bf16* E = (bf16*)(a.ws + WS_E) + (size_t)g * 128 * KA;
    float* A16 = (float*)(a.ws + WS_A16) + (size_t)g * NP * 2;
    if (tid < NP) {
        const int p = tid;
        const double lr = fmin((double)a.in[I_LRE][g * NP + p], -1e-4), li = (double)a.in[I_LIM][g * NP + p];
        const double dt = exp((double)a.in[I_LSTEP][g]);
        const double mg = exp(lr * dt); double sn, cs; sincos(li * dt, &sn, &cs);
        { const double a1r = mg * cs, a1i = mg * sn; double pr = 1.0, pi = 0.0;
          for (int k = 0; k <= LC; ++k) { apow[(k * NP + p) * 2] = (float)pr; apow[(k * NP + p) * 2 + 1] = (float)pi; const double nr = pr * a1r - pi * a1i, ni = pr * a1i + pi * a1r; pr = nr; pi = ni; } }
        const double nr = mg * cs - 1.0, ni = mg * sn, den = lr * lr + li * li;
        const double qre = (nr * lr + ni * li) / den, qim = (ni * lr - nr * li) / den;
        for (int h = 0; h < NH; ++h) { const double br = (double)a.in[I_BRE][(g * NP + p) * NH + h], bi = (double)a.in[I_BIM][(g * NP + p) * NH + h];
            Bb[(p * NH + h) * 2] = (float)(qre * br - qim * bi); Bb[(p * NH + h) * 2 + 1] = (float)(qre * bi + qim * br); }
        A16[p * 2] = apow[(LC * NP + p) * 2]; A16[p * 2 + 1] = apow[(LC * NP + p) * 2 + 1];
    }
    for (int e = tid; e < NH * NP; e += 512) { Cc[e * 2] = a.in[I_CRE][g * NH * NP + e]; Cc[e * 2 + 1] = a.in[I_CIM][g * NH * NP + e]; }
    __syncthreads();
    for (int e = tid; e < LC * 256; e += 512) {
        const int k = e >> 8, ho = (e >> 4) & 15, hi = e & 15; float s = 0.f;
        for (int p = 0; p < NP; ++p) {
            const float cr = Cc[(ho * NP + p) * 2], ci = Cc[(ho * NP + p) * 2 + 1], ar = apow[(k * NP + p) * 2], ai = apow[(k * NP + p) * 2 + 1], br = Bb[(p * NH + hi) * 2], bi = Bb[(p * NH + hi) * 2 + 1];
            const float zr = cr * ar - ci * ai, zi = cr * ai + ci * ar;
            s += zr * br - zi * bi;
        }
        Kk[e] = s;
    }
    __syncthreads();
    for (int e = tid; e < 256 * (KC / 2); e += 512) {
        const int row = e / (KC / 2), kc = (e % (KC / 2)) * 2, j = row >> 4, ho = row & 15; float v[2];
#pragma unroll
        for (int q = 0; q < 2; ++q) { const int k = kc + q;
            if (k < 256) { const int i = k >> 4, hi = k & 15; v[q] = (i <= j) ? Kk[((j - i) * 16 + ho) * 16 + hi] : 0.f; }
            else { const int p = (k - 256) & 63, ri = (k - 256) >> 6; const float cr = Cc[(ho * NP + p) * 2], ci = Cc[(ho * NP + p) * 2 + 1], ar = apow[((j + 1) * NP + p) * 2], ai = apow[((j + 1) * NP + p) * 2 + 1];
                v[q] = ri == 0 ? (cr * ar - ci * ai) : -(cr * ai + ci * ar); } }
        *(unsigned*)(TF + (size_t)row * KC + kc) = cvt_pk_bf16(v[0], v[1]);
    }
    for (int e = tid; e < 128 * (KA / 2); e += 512) {
        const int row = e / (KA / 2), kc = (e % (KA / 2)) * 2, ri = row >> 6, p = row & 63; float v[2];
#pragma unroll
        for (int q = 0; q < 2; ++q) { const int k = kc + q, i = k >> 4, hi = k & 15; const float ar = apow[((LC - 1 - i) * NP + p) * 2], ai = apow[((LC - 1 - i) * NP + p) * 2 + 1], br = Bb[(p * NH + hi) * 2], bi = Bb[(p * NH + hi) * 2 + 1];
            v[q] = ri == 0 ? (ar * br - ai * bi) : (ar * bi + ai * br); }
        *(unsigned*)(E + (size_t)row * KA + kc) = cvt_pk_bf16(v[0], v[1]);
    }
    __syncthreads();
}

__device__ __forceinline__ void s5_scan(const Args& a, int g, int b, LAS unsigned char* lds, int wave, int lane) {
    asm volatile("" : "+v"(lane));
    const float* sloc = (const float*)(a.ws + WS_SLOC) + (size_t)(g * NCH + b * 256 + wave * 32) * 128;
    bf16* AC = (bf16*)(a.ws + WS_AC) + (size_t)(g * NCH + b * 256 + wave * 32) * KC + 256;
    const float* A16 = (const float*)(a.ws + WS_A16) + (size_t)g * NP * 2;
    const float ar = A16[lane * 2], ai = A16[lane * 2 + 1];
    float xr[32], xi[32];
#pragma unroll
    for (int j = 0; j < 32; ++j) { xr[j] = sloc[j * 128 + lane]; xi[j] = sloc[j * 128 + 64 + lane]; }
    float sr = 0.f, si = 0.f;
#pragma unroll
    for (int j = 0; j < 32; ++j) { const float nr = ar * sr - ai * si + xr[j], ni = ar * si + ai * sr + xi[j]; sr = nr; si = ni; }
    LAS float* ex = (LAS float*)lds;
    ex[(wave * 64 + lane) * 2] = sr; ex[(wave * 64 + lane) * 2 + 1] = si;
    float pr = ar, pi = ai;
#pragma unroll
    for (int q = 0; q < 5; ++q) { const float nr = pr * pr - pi * pi, ni = 2.f * pr * pi; pr = nr; pi = ni; }
    __syncthreads();
    float cr = 0.f, ci = 0.f;
    for (int v = 0; v < wave; ++v) { const float er = ex[(v * 64 + lane) * 2], ei = ex[(v * 64 + lane) * 2 + 1]; const float nr = pr * cr - pi * ci + er, ni = pr * ci + pi * cr + ei; cr = nr; ci = ni; }
    sr = cr; si = ci;
#pragma unroll
    for (int j = 0; j < 32; ++j) {
        AC[(size_t)j * KC + lane] = (bf16)(cvt_pk_bf16(sr, 0.f) & 0xffffu); AC[(size_t)j * KC + 64 + lane] = (bf16)(cvt_pk_bf16(si, 0.f) & 0xffffu);
        const float nr = ar * sr - ai * si + xr[j], ni = ar * si + ai * sr + xi[j]; sr = nr; si = ni;
    }
    VM_WAIT(); __syncthreads();
}

constexpr int SGU_LDV = 136;
__device__ __forceinline__ void sgu_unit(const Args& a, int n, int h, LAS unsigned char* lds, int tid, int wave, int lane) {
    asm volatile("" : "+v"(tid), "+v"(lane));
    LAS bf16* Vt = (LAS bf16*)lds;
    LAS float* st = (LAS float*)(lds + 36864);
    const int tok0 = n * 128, fr = lane & 15, fq = lane >> 4;
    const bf16* gv = (const bf16*)(a.ws + WS_GV); const bf16* gu = (const bf16*)(a.ws + WS_GU); bf16* Y = (bf16*)(a.ws + WS_Y);
    if (tid < 128) {
        const float* ls = (const float*)(a.ws + WS_LNST) + (size_t)(tok0 + tid) * 32; float s1 = 0.f, s2 = 0.f;
#pragma unroll
        for (int q = 0; q < 8; ++q) { const f32x4 v = *(const f32x4*)(ls + 4 * q); s1 += v[0] + v[2]; s2 += v[1] + v[3]; }
        const float mu = s1 * (1.0f / 1024.0f), var = s2 * (1.0f / 1024.0f) - mu * mu;
        st[tid * 2] = mu; st[tid * 2 + 1] = 1.0f / sqrtf(var + EPS);
    }
    __syncthreads();
#pragma unroll
    for (int i = 0; i < 4; ++i) {
        const int q = tid + 512 * i, s = q & 127, c8 = q >> 7;
        const u32x4 w = *(const u32x4*)(gv + (size_t)(tok0 + s) * DG + h * 128 + 8 * c8);
        f32x4 v0, v1; unpack8(w, v0, v1);
        const f32x4 g0 = *(const f32x4*)(a.in[I_LNG] + h * 128 + 8 * c8), g1 = *(const f32x4*)(a.in[I_LNG] + h * 128 + 8 * c8 + 4);
        const f32x4 b0 = *(const f32x4*)(a.in[I_LNB] + h * 128 + 8 * c8), b1 = *(const f32x4*)(a.in[I_LNB] + h * 128 + 8 * c8 + 4);
        const float mu = st[s * 2], rstd = st[s * 2 + 1];
        v0 = (v0 - mu) * rstd * g0 + b0; v1 = (v1 - mu) * rstd * g1 + b1;
        const unsigned p0 = cvt_pk_bf16(v0[0], v0[1]), p1 = cvt_pk_bf16(v0[2], v0[3]), p2 = cvt_pk_bf16(v1[0], v1[1]), p3 = cvt_pk_bf16(v1[2], v1[3]);
        LAS bf16* d = Vt + (8 * c8) * SGU_LDV + s;
        d[0 * SGU_LDV] = (bf16)(p0 & 0xffffu); d[1 * SGU_LDV] = (bf16)(p0 >> 16); d[2 * SGU_LDV] = (bf16)(p1 & 0xffffu); d[3 * SGU_LDV] = (bf16)(p1 >> 16);
        d[4 * SGU_LDV] = (bf16)(p2 & 0xffffu); d[5 * SGU_LDV] = (bf16)(p2 >> 16); d[6 * SGU_LDV] = (bf16)(p3 & 0xffffu); d[7 * SGU_LDV] = (bf16)(p3 >> 16);
    }
    __syncthreads();
    f32x4 acc[8];
#pragma unroll
    for (int j = 0; j < 8; ++j) acc[j] = (f32x4){0.f, 0.f, 0.f, 0.f};
    const int t = 16 * wave + fr;
    const float* wrow = a.in[I_SGUW] + ((size_t)h * 128 + t) * 128;
#pragma unroll
    for (int kk = 0; kk < 4; ++kk) {
        if (32 * kk <= 16 * wave + 15) {
            const int s0 = 32 * kk + 8 * fq;
            f32x4 w0 = *(const f32x4*)(wrow + s0), w1 = *(const f32x4*)(wrow + s0 + 4);
#pragma unroll
            for (int q = 0; q < 4; ++q) { if (s0 + q > t) w0[q] = 0.f; if (s0 + 4 + q > t) w1[q] = 0.f; }
            const u32x4 aw = pack8(w0, w1); bf16x8 af; __builtin_memcpy(&af, &aw, 16);
#pragma unroll
            for (int j = 0; j < 8; ++j) {
                const bf16x8 bfr = *(const LAS bf16x8*)(Vt + (16 * j + fr) * SGU_LDV + 32 * kk + 8 * fq);
                acc[j] = __builtin_amdgcn_mfma_f32_16x16x32_bf16(bfr, af, acc[j], 0, 0, 0);
            }
        }
    }
    const float bias = a.in[I_SGUB][h * 128 + t]; float ss = 0.f;
    const size_t tok = (size_t)(tok0 + t);
#pragma unroll
    for (int j = 0; j < 8; ++j) {
        const int c = h * 128 + 16 * j + 4 * fq;
        const u32x2 gw = *(const u32x2*)(gu + tok * DG + c);
        f32x4 o; o[0] = (acc[j][0] + bias) * bf_lo(gw.x); o[1] = (acc[j][1] + bias) * bf_hi(gw.x); o[2] = (acc[j][2] + bias) * bf_lo(gw.y); o[3] = (acc[j][3] + bias) * bf_hi(gw.y);
        ss += (o[0] * o[0] + o[1] * o[1]) + (o[2] * o[2] + o[3] * o[3]);
        u32x2 ow; ow.x = cvt_pk_bf16(o[0], o[1]); ow.y = cvt_pk_bf16(o[2], o[3]);
        *(u32x2*)(Y + tok * D + 1024 + c) = ow;
    }
    ss += __shfl_xor(ss, 16); ss += __shfl_xor(ss, 32);
    if (fq == 0) ((float*)(a.ws + WS_SSQB))[tok * 8 + h] = ss;
    __syncthreads();
}

constexpr int PER_PHASE = 9;
__global__ void __launch_bounds__(NWAVES * 64, 2) hybrid_fwd(Args args) {
    extern __shared__ __attribute__((aligned(16))) unsigned char lds_raw[];
    LAS unsigned char* lds = (LAS unsigned char*)lds_raw;
    volatile LAS unsigned* MISC = (volatile LAS unsigned*)(lds + MISC_OFF);
    const int tid = threadIdx.x, lane = tid & 63, wave = __builtin_amdgcn_readfirstlane(tid >> 6);
    const int G = gridDim.x, bx = blockIdx.x;
    const int vcu = (G % 8 == 0) ? (bx % 8) * (G / 8) + bx / 8 : bx;
    unsigned char* ws = args.ws;
    for (int u = tid; u < (LDS_BYTES - LDSCTL_OFF) / 4; u += NWAVES * 64) ((LAS unsigned*)(lds + LDSCTL_OFF))[u] = 0u;
    __syncthreads();
    XcdBarrier bar; bar.bar = (unsigned*)(ws + WS_CTL) + CW_BAR + args.li * XCD_BAR_WORDS; bar.x = 0; bar.st = nullptr;
    if (MK_N_LAUNCHES != PER_PHASE) bar = xcd_barrier_post((unsigned*)(ws + WS_CTL) + CW_BAR + args.li * XCD_BAR_WORDS, MISC + 8);
    const int lo = args.ph_lo, hi = args.ph_hi;
#ifndef PHASE_MASK
#define PHASE_MASK 0x1ff
#endif
#define IN(k) (((PHASE_MASK >> (k)) & 1) && lo <= (k) && (k) < hi)
#ifndef PROBE_PHASE
#define PROBE_PHASE (-1)
#endif
#define STAMP(k) do { if (PROBE_PHASE >= 0 && bx == 0 && tid == 0) MISC[12 + (k)] = (unsigned)__builtin_amdgcn_s_memrealtime(); } while (0)
#define SEAM(k) do { if (IN(k) && IN((k) + 1)) xcd_barrier(bar); STAMP((k) + 1); } while (0)
    STAMP(0);
    const int gw = vcu * NWAVES + wave, ngw = G * NWAVES;
    const bool split = (G == 256);
    const int roleA = split ? (((bx >> 3) & 1) == 0) : 1, roleB = split ? !roleA : 1;
    const int ridx = split ? (((bx >> 4) << 3) | (bx & 7)) : bx, RG = split ? 128 : G;

    bf16* WT_in = (bf16*)(ws + WS_WIN); bf16* WT_glu = (bf16*)(ws + WS_WGLU); bf16* WT_out = (bf16*)(ws + WS_WOUT); bf16* WT_ffi = (bf16*)(ws + WS_WFFI);
    bf16* WT_ffo = (bf16*)(ws + WS_WFFO); bf16* WT_g = (bf16*)(ws + WS_WG); bf16* WT_ple = (bf16*)(ws + WS_WPLE);
    bf16* XB = (bf16*)(ws + WS_XB); bf16* PB = (bf16*)(ws + WS_PB); bf16* AC = (bf16*)(ws + WS_AC);

    if (IN(0)) {
        LAS float* scr = (LAS float*)(lds + wave * 16384);
        if (bx < NG) p0_s5_tables(args, bx, (LAS float*)lds, tid);
        p0_transpose<0>(args.in[I_WIN], D, NIN, args.in[I_NMIXG], nullptr, WT_in, scr, gw, ngw, lane);
        p0_transpose<0>(args.in[I_GLUW], DS, DS, nullptr, nullptr, WT_glu, scr, gw, ngw, lane);
        p0_transpose<0>(args.in[I_WOUT], D, D, args.in[I_ONSSM], args.in[I_ONSGU], WT_out, scr, gw, ngw, lane);
        p0_transpose<0>(args.in[I_WPLE], PLE, D, nullptr, nullptr, WT_ple, scr, gw, ngw, lane);
        float* r0 = (float*)(ws + WS_R0);
        for (int m = gw; m < T; m += ngw) {
            const f32x4* xr = (const f32x4*)(args.in[I_X] + (size_t)m * D) + lane; u32x2* o = (u32x2*)(XB + (size_t)m * D) + lane; float ss = 0.f;
#pragma unroll
            for (int j = 0; j < 8; ++j) { const f32x4 v = xr[64 * j]; ss += (v[0] * v[0] + v[1] * v[1]) + (v[2] * v[2] + v[3] * v[3]); u32x2 w; w.x = cvt_pk_bf16(v[0], v[1]); w.y = cvt_pk_bf16(v[2], v[3]); o[64 * j] = w; }
            ss = wave_sum(ss);
            if (lane == 0) r0[m] = 1.0f / sqrtf(ss * (1.0f / 2048.0f) + EPS);
        }
        for (int e = gw * 64 + lane; e < T * PLE / 8; e += ngw * 64) { const f32x4 v0 = *((const f32x4*)args.in[I_P] + 2 * e), v1 = *((const f32x4*)args.in[I_P] + 2 * e + 1); *((u32x4*)PB + e) = pack8(v0, v1); }
    }
    SEAM(0);
    if (IN(1)) {
        pg8::SchedTiles S; S.init(XB, WT_in, T, NIN, D, D, G, bx);
        EpiIn E{(const float*)(ws + WS_R0), AC, (bf16*)(ws + WS_GU), (bf16*)(ws + WS_GV), (float*)(ws + WS_LNST)};
        pg8::gemm_phase<EpiIn, pg8::SchedTiles, true>(lds, D, D, D, S, E, tid);
        { const int ntile = (T / 256) * (NIN / 256), nfull = ntile % G;
          if (nfull == 0) p0_transpose<1>(args.in[I_WFFI], D, 2 * FF, args.in[I_NFFNG], nullptr, WT_ffi, (LAS float*)(lds + wave * 16384), gw, ngw, lane);
          else if (bx >= nfull) p0_transpose<1>(args.in[I_WFFI], D, 2 * FF, args.in[I_NFFNG], nullptr, WT_ffi, (LAS float*)(lds + wave * 16384), (bx - nfull) * NWAVES + wave, (G - nfull) * NWAVES, lane); }
    }
    SEAM(1);
    if (IN(2)) {
#ifndef P2_SKIP_A
        if (roleA) {
            for (int un = ridx; un < 2 * NG; un += RG) {
                const int g = un >> 1, b = un & 1;
                pg8::SchedOne S; S.u.A = (const char*)(AC + (size_t)(g * NCH + b * 256) * KC); S.u.pm = b; S.u.pn = 0; S.u.g = g;
                S.u.B = (const char*)((const bf16*)(ws + WS_E) + (size_t)g * 128 * KA);
                EpiSloc E1{(float*)(ws + WS_SLOC)};
                pg8::gemm_phase<EpiSloc, pg8::SchedOne, false>(lds, KA, KC, KA, S, E1, tid);
                VM_WAIT(); __syncthreads();
                s5_scan(args, g, b, lds, wave, lane);
                S.u.B = (const char*)((const bf16*)(ws + WS_TF) + (size_t)g * 256 * KC);
                EpiS5Out E2{AC, args.in[I_SD], (bf16*)(ws + WS_YAPRE)};
                pg8::gemm_phase<EpiS5Out, pg8::SchedOne, false>(lds, KC, KC, KC, S, E2, tid);
                __syncthreads();
            }
        }
#endif
#ifndef P2_SKIP_B
        if (roleB) {
            for (int un = ridx; un < 512; un += RG) sgu_unit(args, un >> 3, un & 7, lds, tid, wave, lane);
        }
#endif
    }
    SEAM(2);
    if (IN(3)) {
        if (roleA) {
            pg8::SchedTiles S; S.init((const bf16*)(ws + WS_YAPRE), WT_glu, T, DS, DS, DS, RG, ridx);
            EpiGlu E{(const bf16*)(ws + WS_YAPRE), args.in[I_GLUB], (bf16*)(ws + WS_Y), (float*)(ws + WS_SSQA)};
            pg8::gemm_phase<EpiGlu, pg8::SchedTiles, true>(lds, DS, DS, DS, S, E, tid);
        }
        if (roleB) {
            pg8::SchedTiles S; S.init(PB, WT_ple, T, D, PLE, PLE, RG, ridx);
            EpiProj E{(bf16*)(ws + WS_PROJ)};
            pg8::gemm_phase<EpiProj, pg8::SchedTiles, true>(lds, PLE, PLE, PLE, S, E, tid);
        }
    }
    SEAM(3);
    if (IN(4)) {
        pg8::SchedTiles S; S.init((const bf16*)(ws + WS_Y), WT_out, T, D, D, D, G, bx);
        EpiOut E{(const float*)(ws + WS_SSQA), (const float*)(ws + WS_SSQB), args.in[I_X], args.out, XB, (float*)(ws + WS_SSQ1)};
        pg8::gemm_phase<EpiOut, pg8::SchedTiles, true>(lds, D, D, D, S, E, tid);
    }
    SEAM(4);
    if (IN(5)) {
        pg8::SchedTiles S; S.init(XB, WT_ffi, T, 2 * FF, D, D, G, bx);
        EpiFfnIn E{(const float*)(ws + WS_SSQ1), (bf16*)(ws + WS_H)};
        pg8::gemm_phase<EpiFfnIn, pg8::SchedTiles, true>(lds, D, D, D, S, E, tid);
        { const int ntile = (T / 256) * (2 * FF / 256), nfull = ntile % G; LAS float* scr = (LAS float*)(lds + wave * 16384);
          const int cgw = (nfull == 0) ? gw : (bx - nfull) * NWAVES + wave, cngw = (nfull == 0) ? ngw : (G - nfull) * NWAVES;
          if (nfull == 0 || bx >= nfull) {
              p0_transpose<0>(args.in[I_WFFO], FF, D, nullptr, nullptr, WT_ffo, scr, cgw, cngw, lane);
              p0_transpose<0>(args.in[I_WG], D, D, args.in[I_NPLEG], nullptr, WT_g, scr, cgw, cngw, lane); } }
    }
    SEAM(5);
    if (IN(6)) {
        pg8::SchedTiles S; S.init((const bf16*)(ws + WS_H), WT_ffo, T, D, FF, FF, G, bx);
        EpiFfnOut E{args.out, XB, (float*)(ws + WS_SSQ2)};
        pg8::gemm_phase<EpiFfnOut, pg8::SchedTiles, true>(lds, FF, FF, FF, S, E, tid);
    }
    SEAM(6);
    if (IN(7)) {
        pg8::SchedTiles S; S.init(XB, WT_g, T, D, D, D, G, bx);
        EpiPle E{(const float*)(ws + WS_SSQ2), args.in[I_BG], (const bf16*)(ws + WS_PROJ), args.out, (float*)(ws + WS_SSQ3)};
        pg8::gemm_phase<EpiPle, pg8::SchedTiles, true>(lds, D, D, D, S, E, tid);
    }
    SEAM(7);
    if (IN(8)) {
        const float* ssq3 = (const float*)(ws + WS_SSQ3);
        for (int m = gw; m < T; m += ngw) {
            float s = (lane < 32) ? ssq3[(size_t)m * 32 + lane] : 0.f; s = wave_sum(s);
            const float r = 1.0f / sqrtf(s * (1.0f / 2048.0f) + EPS);
            f32x4* xr = (f32x4*)(args.out + (size_t)m * D) + lane; const f32x4* gr = (const f32x4*)args.in[I_FNG] + lane;
#pragma unroll
            for (int j = 0; j < 8; ++j) { const f32x4 v = xr[64 * j] * r * gr[64 * j]; xr[64 * j] = v; }
        }
    }
    STAMP(9);
    if (PROBE_PHASE >= 0 && bx == 0 && tid == 0) {
        const unsigned span = MISC[12 + PROBE_PHASE + 1] - MISC[12 + PROBE_PHASE], t9 = MISC[12 + 9];
        while ((unsigned)__builtin_amdgcn_s_memrealtime() - t9 < span) __builtin_amdgcn_s_sleep(8);
    }
#undef IN
#undef SEAM
}

extern "C" void kernel_launch(void* const* d_in, const int* in_sizes, int n_in, void* d_out, int out_size, void* d_ws, size_t ws_size, hipStream_t stream) {
    static int grid = 0;
    if (grid == 0) {
        if (n_in != 29 || in_sizes[0] != T * D || out_size != T * D || ws_size < WS_END) {
            fprintf(stderr, "kernel_launch: shape/workspace mismatch: n_in %d in0 %d out %d ws %zu (need %zu); nothing launched\n", n_in, n_in > 0 ? in_sizes[0] : -1, out_size, ws_size, (size_t)WS_END); grid = -1; return; }
        int dev = 0, cus = 0, per_cu = 0;
        if (hipGetDevice(&dev) != hipSuccess || hipDeviceGetAttribute(&cus, hipDeviceAttributeMultiprocessorCount, dev) != hipSuccess) { fprintf(stderr, "kernel_launch: device query failed\n"); grid = -1; return; }
        if (hipFuncSetAttribute((const void*)hybrid_fwd, hipFuncAttributeMaxDynamicSharedMemorySize, LDS_BYTES) != hipSuccess) { fprintf(stderr, "kernel_launch: hipFuncSetAttribute failed\n"); grid = -1; return; }
        if (hipOccupancyMaxActiveBlocksPerMultiprocessor(&per_cu, (const void*)hybrid_fwd, NWAVES * 64, LDS_BYTES) != hipSuccess || per_cu < 1) { fprintf(stderr, "kernel_launch: occupancy query says %d blocks per CU; nothing launched\n", per_cu); (void)hipGetLastError(); grid = -1; return; }
        grid = cus;
        fprintf(stderr, "kernel_launch: grid %d (CUs %d, occupancy %d/CU), ws need %zu have %zu\n", grid, cus, per_cu, (size_t)WS_END, ws_size);
    }
    if (grid < 0) return;
    if (hipMemsetAsync((char*)d_ws + WS_CTL, 0, CTL_ZERO_BYTES, stream) != hipSuccess) { fprintf(stderr, "kernel_launch: memset failed\n"); return; }
    Args a{};
    for (int i = 0; i < 29; ++i) a.in[i] = (const float*)d_in[i];
    a.out = (float*)d_out; a.ws = (unsigned char*)d_ws;
    if (MK_N_LAUNCHES == 1) {
        a.ph_lo = 0; a.ph_hi = PER_PHASE; a.li = 0;
        void* kargs[] = {&a};
        const hipError_t le = hipLaunchCooperativeKernel((const void*)hybrid_fwd, dim3(grid), dim3(NWAVES * 64), kargs, LDS_BYTES, stream);
        if (le != hipSuccess) fprintf(stderr, "kernel_launch: cooperative launch failed: %s (grid %d)\n", hipGetErrorName(le), grid);
    } else {
        for (int li = 0; li < PER_PHASE; ++li) {
            a.ph_lo = li; a.ph_hi = li + 1; a.li = 0;
            hipLaunchKernelGGL(hybrid_fwd, dim3(grid), dim3(NWAVES * 64), LDS_BYTES, stream, a);
            const hipError_t le = hipPeekAtLastError();
            if (le != hipSuccess) { fprintf(stderr, "kernel_launch: launch %d failed: %s\n", li, hipGetErrorName(le)); break; }
        }
    }
}
```

```cpp
#include <hip/hip_runtime.h>
#include <cstdio>
#include <cstdint>

#ifndef MK_N_LAUNCHES
#define MK_N_LAUNCHES 1
#endif

#define LAS __attribute__((address_space(3)))
#define GAS __attribute__((address_space(1)))
typedef unsigned short bf16;
typedef short bf16x8 __attribute__((ext_vector_type(8)));
typedef float f32x4 __attribute__((ext_vector_type(4)));
typedef float f32x2 __attribute__((ext_vector_type(2)));
typedef unsigned u32x4 __attribute__((ext_vector_type(4)));
typedef unsigned u32x2 __attribute__((ext_vector_type(2)));
typedef GAS unsigned gu32;

constexpr int T = 8192;
constexpr int SEQ = 4096;
constexpr int D = 2048, DS = 1024, DG = 1024, NIN = 3072, FF = 5632, PLE = 256;
constexpr int NG = 64, NP = 64, NH = 16;
constexpr int LC = 16;
constexpr int NCH = T / LC;
constexpr int KC = LC * NH + 2 * NP;
constexpr int KA = LC * NH;
constexpr float EPS = 1e-6f;

constexpr size_t MiB = 1u << 20;
constexpr size_t WS_CTL = 0, CTL_ZERO_BYTES = 64 * 1024;
constexpr size_t WS_WFFI = 1 * MiB;
constexpr size_t WS_WFFO = WS_WFFI + 44 * MiB;
constexpr size_t WS_WG   = WS_WFFO + 22 * MiB;
constexpr size_t WS_WPLE = WS_WG + 8 * MiB;
constexpr size_t WS_XB   = WS_WPLE + 1 * MiB;
constexpr size_t WS_PROJ = WS_XB + 32 * MiB;
constexpr size_t WS_SSQA = WS_PROJ + 32 * MiB;
constexpr size_t WS_SSQB = WS_SSQA + 1 * MiB;
constexpr size_t WS_SSQ1 = WS_SSQB + 1 * MiB;
constexpr size_t WS_SSQ2 = WS_SSQ1 + 1 * MiB;
constexpr size_t WS_SSQ3 = WS_SSQ2 + 1 * MiB;
constexpr size_t WS_LNST = WS_SSQ3 + 1 * MiB;
constexpr size_t WS_R0   = WS_LNST + 1 * MiB;
constexpr size_t WS_EARLY = WS_R0 + 1 * MiB;
constexpr size_t WS_WIN  = WS_EARLY;
constexpr size_t WS_WGLU = WS_WIN + 12 * MiB;
constexpr size_t WS_WOUT = WS_WGLU + 2 * MiB;
constexpr size_t WS_TF   = WS_WOUT + 8 * MiB;
constexpr size_t WS_E    = WS_TF + 12 * MiB;
constexpr size_t WS_A16  = WS_E + 5 * MiB;
constexpr size_t WS_AC   = WS_A16 + 1 * MiB;
constexpr size_t WS_GU   = WS_AC + 24 * MiB;
constexpr size_t WS_GV   = WS_GU + 16 * MiB;
constexpr size_t WS_SLOC = WS_GV + 16 * MiB;
constexpr size_t WS_YAPRE = WS_SLOC + 16 * MiB;
constexpr size_t WS_Y    = WS_YAPRE + 16 * MiB;
constexpr size_t WS_PB   = WS_Y + 32 * MiB;
constexpr size_t WS_EARLY_END = WS_PB + 4 * MiB;
constexpr size_t WS_H    = WS_EARLY;
constexpr size_t WS_END  = (WS_EARLY_END > WS_H + 88 * MiB) ? WS_EARLY_END : WS_H + 88 * MiB;

constexpr int CW_BAR = 4096;

constexpr int RING_BYTES = 131072;
constexpr int LDSCTL_OFF = RING_BYTES, MISC_OFF = LDSCTL_OFF + 320;
constexpr int LDS_BYTES = 147456;
constexpr int NWAVES = 8;

#define RLX_AGENT __ATOMIC_RELAXED, __HIP_MEMORY_SCOPE_AGENT
#define LDS_WAIT() asm volatile("s_waitcnt lgkmcnt(0)" ::: "memory")
#define VM_WAIT() asm volatile("s_waitcnt vmcnt(0)" ::: "memory")
__device__ __forceinline__ unsigned cvt_pk_bf16(float lo, float hi) { unsigned r; asm volatile("v_cvt_pk_bf16_f32 %0, %1, %2" : "=v"(r) : "v"(lo), "v"(hi)); return r; }
__device__ __forceinline__ float bf_lo(unsigned w) { return __uint_as_float(w << 16); }
__device__ __forceinline__ float bf_hi(unsigned w) { return __uint_as_float(w & 0xffff0000u); }
__device__ __forceinline__ float fast_sigmoid(float y) { return __builtin_amdgcn_rcpf(1.0f + __builtin_amdgcn_exp2f(-1.4426950408889634f * y)); }
__device__ __forceinline__ float gelu_tanh(float x) { const float y = 1.5957691216057308f * (x + 0.044715f * x * x * x); return x * fast_sigmoid(y); }
__device__ __forceinline__ float silu(float x) { return x * fast_sigmoid(x); }
__device__ __forceinline__ float wave_sum(float v) {
#pragma unroll
    for (int o = 1; o < 64; o <<= 1) v += __shfl_xor(v, o);
    return v;
}

namespace pg8 {
constexpr int BM = 256, BK = 64, HALF = 128, HTB = HALF * BK * 2, NXCD = 8, WGM = 8;
__host__ __device__ __forceinline__ int lds_byte(int r, int c) { const int st = (r >> 4) * 2 + (c >> 5), rr = r & 15, cc = c & 31, ob = rr * 64 + cc * 2; return st * 1024 + (ob ^ (((ob >> 9) & 1) << 5)); }
__host__ __device__ __forceinline__ void stage_rc(int b, int& R, int& C) { const int st = b / 1024, sb = b % 1024, swz = sb ^ (((sb >> 9) & 1) << 5); R = (st >> 1) * 16 + swz / 64; C = (st & 1) * 32 + (swz % 64) / 2; }
__host__ __device__ __forceinline__ int perm32(int rho) { const int n = rho >> 4, i = rho & 15; return 8 * (i >> 2) + 4 * n + (i & 3); }

struct Unit { const char* A; const char* B; int pm, pn, g; };

struct SchedTiles {
    const char* A; const char* B; size_t tstepA, tstepB; int nM, nN, nwg, G, c, pn0;
    __device__ __forceinline__ void init(const void* A_, const void* B_, int M, int N, int lda, int ldb, int G_, int c_, int pn0_ = 0) {
        pn0 = pn0_; A = (const char*)A_; B = (const char*)B_; tstepA = (size_t)BM * lda * 2; tstepB = (size_t)BM * ldb * 2; nM = M / BM; nN = N / BM; nwg = nM * nN; G = G_; c = c_; }
    __device__ __forceinline__ bool next(int i, Unit& u) const {
        const int L = i * G + c; if (L >= nwg) return false;
        int wgid = L; { const int q = nwg / NXCD, r = nwg % NXCD, xcd = wgid % NXCD, off = wgid / NXCD; wgid = (xcd < r ? xcd * (q + 1) : r * (q + 1) + (xcd - r) * q) + off; }
        const int nig = WGM * nN, gid = wgid / nig, fm = gid * WGM, gsz = (nM - fm) < WGM ? (nM - fm) : WGM;
        u.pm = fm + ((wgid % nig) % gsz); u.pn = (wgid % nig) / gsz; u.g = 0;
        u.A = A + (size_t)u.pm * tstepA; u.B = B + (size_t)u.pn * tstepB; u.pn += pn0; return true;
    }
};
struct SchedOne { Unit u; __device__ __forceinline__ bool next(int i, Unit& o) const { if (i != 0) return false; o = u; return true; } };

template <class Epi, class Sched, bool ALIGN_EPI>
__device__ __forceinline__ void gemm_phase(LAS unsigned char* lds, const int K, const int lda, const int ldb, const Sched& S, const Epi& E, int tid) {
    asm volatile("" : "+v"(tid));
    const int wid = __builtin_amdgcn_readfirstlane(tid >> 6), lane = tid & 63, wr = wid >> 2, wc = wid & 3, fr = lane & 15, fq = lane >> 4;
    const int nt = K / BK;
    unsigned voffA[2], voffB[2];
#pragma unroll
    for (int i = 0; i < 2; ++i) { int R, C; stage_rc(tid * 16 + i * 8192, R, C); const int Rb = (R & ~31) + perm32(R & 31);
        voffA[i] = (unsigned)(R * lda + C) * 2u; voffB[i] = (unsigned)(Rb * ldb + C) * 2u; }
    const size_t kstep = (size_t)(BK * 2);
    const size_t hstepA = (size_t)HALF * lda * 2, hstepB = (size_t)HALF * ldb * 2;
    const unsigned ldsw = (unsigned)wid * 1024u;
    const int aoff = lds_byte(wr * 64 + fr, fq * 8), boff = lds_byte(wc * 32 + fr, fq * 8);
#define PG8_SA(b, h) (((b) * 2 + (h)) * HTB)
#define PG8_SB(b, h) ((4 + (b) * 2 + (h)) * HTB)
#define PG8_STAGE(bufoff, gbase, voff) do { _Pragma("unroll") for (int _i = 0; _i < 2; ++_i) \
        __builtin_amdgcn_global_load_lds((const unsigned*)((const char*)(gbase) + (voff)[_i]), (LAS unsigned*)(lds + (bufoff) + ldsw + _i * 8192), 16, 0, 0); } while (0)
#define PG8_LDA(dst, b, h) do { _Pragma("unroll") for (int m = 0; m < 4; ++m) _Pragma("unroll") for (int k = 0; k < 2; ++k) dst[m][k] = *(const LAS bf16x8*)(lds + PG8_SA(b, h) + aoff + m * 2048 + k * 1024); } while (0)
#define PG8_LDB(dst, b, h) do { _Pragma("unroll") for (int n = 0; n < 2; ++n) _Pragma("unroll") for (int k = 0; k < 2; ++k) dst[n][k] = *(const LAS bf16x8*)(lds + PG8_SB(b, h) + boff + n * 2048 + k * 1024); } while (0)
#define PG8_MMA(ai, bj, At, Bt) do { __builtin_amdgcn_s_setprio(1); _Pragma("unroll") for (int m = 0; m < 4; ++m) _Pragma("unroll") for (int n = 0; n < 2; ++n) _Pragma("unroll") for (int k = 0; k < 2; ++k) \
        acc[ai][bj][m][n] = __builtin_amdgcn_mfma_f32_16x16x32_bf16(Bt[n][k], At[m][k], acc[ai][bj][m][n], 0, 0, 0); __builtin_amdgcn_s_setprio(0); } while (0)
#define PG8_WAIT_V(n) asm volatile("s_waitcnt vmcnt(" #n ")" ::: "memory")
#define PG8_WAIT_L(n) asm volatile("s_waitcnt lgkmcnt(" #n ")" ::: "memory")
#define PG8_BAR __builtin_amdgcn_s_barrier()
#define PG8_SCHED __builtin_amdgcn_sched_barrier(0)
    Unit cur, nxt; int ui = 0;
    if (!S.next(0, cur)) return;
    f32x4 acc[2][2][4][2];
#pragma unroll
    for (int a = 0; a < 2; ++a)
#pragma unroll
        for (int b = 0; b < 2; ++b)
#pragma unroll
            for (int m = 0; m < 4; ++m)
#pragma unroll
                for (int n = 0; n < 2; ++n) acc[a][b][m][n] = (f32x4){0.f, 0.f, 0.f, 0.f};
    bf16x8 At[4][2], B0[2][2], B1[2][2];
    const char* cA = cur.A; const char* cB = cur.B;
    PG8_STAGE(PG8_SB(0, 0), cB, voffB); PG8_STAGE(PG8_SB(0, 1), cB + hstepB, voffB); PG8_STAGE(PG8_SA(0, 0), cA, voffA); PG8_STAGE(PG8_SA(0, 1), cA + hstepA, voffA);
    if (wr == 1) PG8_BAR;
    PG8_WAIT_V(2); PG8_BAR;
    PG8_STAGE(PG8_SB(1, 0), cB + kstep, voffB); PG8_STAGE(PG8_SA(1, 0), cA + kstep, voffA); PG8_STAGE(PG8_SB(1, 1), cB + hstepB + kstep, voffB);
    PG8_WAIT_V(6); PG8_BAR;
    for (;;) {
        const bool has_next = S.next(ui + 1, nxt);
        const char* nA = has_next ? nxt.A : cA; const char* nB = has_next ? nxt.B : cB;
        for (int t = 0; t < nt; t += 2) {
            const bool last = (t == nt - 2);
            const char* a1 = cA + (size_t)(t + 1) * kstep;
            const char* a2 = last ? nA : cA + (size_t)(t + 2) * kstep; const char* b2 = last ? nB : cB + (size_t)(t + 2) * kstep;
            const char* a3 = a2 + kstep; const char* b3 = b2 + kstep;
            if constexpr (Epi::MID) { if (t == (nt >> 1)) E.mid(acc, cur, wr, wc, fr, fq); }
            PG8_LDB(B0, 0, 0); PG8_LDB(B1, 0, 1); PG8_SCHED; PG8_LDA(At, 0, 0); PG8_STAGE(PG8_SA(1, 1), a1 + hstepA, voffA);
            PG8_WAIT_V(8); PG8_WAIT_L(0); PG8_BAR; PG8_MMA(0, 0, At, B0); PG8_MMA(0, 1, At, B1); PG8_BAR; PG8_SCHED;
            PG8_LDA(At, 0, 1); PG8_STAGE(PG8_SB(0, 0), b2, voffB); PG8_STAGE(PG8_SB(0, 1), b2 + hstepB, voffB); PG8_STAGE(PG8_SA(0, 0), a2, voffA);
            PG8_WAIT_V(8); PG8_WAIT_L(0); PG8_BAR; PG8_MMA(1, 0, At, B0); PG8_MMA(1, 1, At, B1); PG8_BAR; PG8_SCHED;
            PG8_LDB(B0, 1, 0); PG8_LDB(B1, 1, 1); PG8_SCHED; PG8_LDA(At, 1, 0); PG8_STAGE(PG8_SA(0, 1), a2 + hstepA, voffA);
            PG8_WAIT_V(8); PG8_WAIT_L(0); PG8_BAR; PG8_MMA(0, 0, At, B0); PG8_MMA(0, 1, At, B1); PG8_BAR; PG8_SCHED;
            PG8_LDA(At, 1, 1); PG8_STAGE(PG8_SB(1, 0), b3, voffB); PG8_STAGE(PG8_SB(1, 1), b3 + hstepB, voffB); PG8_STAGE(PG8_SA(1, 0), a3, voffA);
            PG8_WAIT_V(8); PG8_WAIT_L(0); PG8_BAR; PG8_MMA(1, 0, At, B0); PG8_MMA(1, 1, At, B1); PG8_BAR; PG8_SCHED;
        }
        if constexpr (ALIGN_EPI) { if (wr == 0) PG8_BAR; }
        E(acc, cur, wr, wc, fr, fq);
        if (!has_next) break;
#pragma unroll
        for (int a = 0; a < 2; ++a)
#pragma unroll
            for (int b = 0; b < 2; ++b)
#pragma unroll
                for (int m = 0; m < 4; ++m)
#pragma unroll
                    for (int n = 0; n < 2; ++n) acc[a][b][m][n] = (f32x4){0.f, 0.f, 0.f, 0.f};
        cur = nxt; cA = nA; cB = nB; ++ui;
        if constexpr (ALIGN_EPI) { if (wr == 1) PG8_BAR; }
    }
    PG8_WAIT_V(0);
    if constexpr (!ALIGN_EPI) { if (wr == 0) PG8_BAR; }
    PG8_BAR;
#undef PG8_SA
#undef PG8_SB
#undef PG8_STAGE
#undef PG8_LDA
#undef PG8_LDB
#undef PG8_MMA
#undef PG8_WAIT_V
#undef PG8_WAIT_L
#undef PG8_BAR
#undef PG8_SCHED
}
}
using pg8::Unit;

#define EPI_ROWS(ai, m) _Pragma("unroll") for (int ai = 0; ai < 2; ++ai) _Pragma("unroll") for (int m = 0; m < 4; ++m)
typedef f32x4 acc_t[2][2][4][2];
#define EPI_FENCE(m) do { if ((m) & 1) asm volatile("" ::: "memory"); } while (0)

__device__ __forceinline__ u32x4 pack8(f32x4 v0, f32x4 v1) { u32x4 w; w.x = cvt_pk_bf16(v0[0], v0[1]); w.y = cvt_pk_bf16(v0[2], v0[3]); w.z = cvt_pk_bf16(v1[0], v1[1]); w.w = cvt_pk_bf16(v1[2], v1[3]); return w; }
__device__ __forceinline__ float sumsq8(f32x4 a, f32x4 b) { return ((a[0] * a[0] + a[1] * a[1]) + (a[2] * a[2] + a[3] * a[3])) + ((b[0] * b[0] + b[1] * b[1]) + (b[2] * b[2] + b[3] * b[3])); }
__device__ __forceinline__ float sum8(f32x4 a, f32x4 b) { return ((a[0] + a[1]) + (a[2] + a[3])) + ((b[0] + b[1]) + (b[2] + b[3])); }
__device__ __forceinline__ void unpack8(u32x4 w, f32x4& a, f32x4& b) { a = (f32x4){bf_lo(w.x), bf_hi(w.x), bf_lo(w.y), bf_hi(w.y)}; b = (f32x4){bf_lo(w.z), bf_hi(w.z), bf_lo(w.w), bf_hi(w.w)}; }
template <int NPART> __device__ __forceinline__ float row_partials(const float* base, int row, int fq) {
    float s;
    if constexpr (NPART == 32) { const f32x4 a = *(const f32x4*)(base + (size_t)row * 32 + 8 * fq), b = *(const f32x4*)(base + (size_t)row * 32 + 8 * fq + 4); s = sum8(a, b); }
    else if constexpr (NPART == 16) { const f32x4 a = *(const f32x4*)(base + (size_t)row * 16 + 4 * fq); s = (a[0] + a[1]) + (a[2] + a[3]); }
    else { const f32x2 a = *(const f32x2*)(base + (size_t)row * 8 + 2 * fq); s = a[0] + a[1]; }
    s += __shfl_xor(s, 16); s += __shfl_xor(s, 32); return s;
}

struct EpiIn {
    static constexpr bool MID = false;
    const float* r0; bf16* AC; bf16* gu; bf16* gv; float* lnst;
    __device__ __forceinline__ void mid(acc_t&, const Unit&, int, int, int, int) const {}
    __device__ __forceinline__ void operator()(const acc_t& acc, const Unit& u, int wr, int wc, int fr, int fq) const {
        asm volatile("" : "+v"(fr), "+v"(fq));
        const int sect = u.pn >> 2;
        EPI_ROWS(ai, m) {
            const int row = u.pm * 256 + ai * 128 + wr * 64 + m * 16 + fr; const float rs = r0[row];
            float s1 = 0.f, s2 = 0.f;
#pragma unroll
            for (int bj = 0; bj < 2; ++bj) {
                const int col = u.pn * 256 + bj * 128 + wc * 32 + 8 * fq;
                f32x4 v0 = acc[ai][bj][m][0] * rs, v1 = acc[ai][bj][m][1] * rs;
                if (sect == 0) {
                    const int g = col >> 4, hi0 = col & 15, chunk = row >> 4, i = row & 15;
                    *(u32x4*)(AC + ((size_t)(g * NCH + chunk) * KC + i * 16 + hi0)) = pack8(v0, v1);
                } else {
#pragma unroll
                    for (int j = 0; j < 4; ++j) { v0[j] = gelu_tanh(v0[j]); v1[j] = gelu_tanh(v1[j]); }
                    if (sect == 1) *(u32x4*)(gu + (size_t)row * DG + (col - 1024)) = pack8(v0, v1);
                    else { *(u32x4*)(gv + (size_t)row * DG + (col - 2048)) = pack8(v0, v1); s1 += sum8(v0, v1); s2 += sumsq8(v0, v1); }
                }
            }
            if (sect == 2) {
                s1 += __shfl_xor(s1, 16); s1 += __shfl_xor(s1, 32); s2 += __shfl_xor(s2, 16); s2 += __shfl_xor(s2, 32);
                if (fq == 0) *(f32x2*)(lnst + ((size_t)row * 16 + (u.pn - 8) * 4 + wc) * 2) = (f32x2){s1, s2};
            }
        }
    }
};
struct EpiSloc {
    static constexpr bool MID = false;
    float* sloc;
    __device__ __forceinline__ void mid(acc_t&, const Unit&, int, int, int, int) const {}
    __device__ __forceinline__ void operator()(const acc_t& acc, const Unit& u, int wr, int wc, int fr, int fq) const {
        asm volatile("" : "+v"(fr), "+v"(fq));
        EPI_ROWS(ai, m) {
            const int row = u.pm * 256 + ai * 128 + wr * 64 + m * 16 + fr;
            float* o = sloc + ((size_t)(u.g * NCH + row) * 128 + wc * 32 + 8 * fq);
            *(f32x4*)o = acc[ai][0][m][0]; *(f32x4*)(o + 4) = acc[ai][0][m][1];
        }
    }
};
struct EpiS5Out {
    static constexpr bool MID = false;
    const bf16* AC; const float* dvec; bf16* yapre;
    __device__ __forceinline__ void mid(acc_t&, const Unit&, int, int, int, int) const {}
    __device__ __forceinline__ void operator()(const acc_t& acc, const Unit& u, int wr, int wc, int fr, int fq) const {
        asm volatile("" : "+v"(fr), "+v"(fq));
        const int ho0 = 8 * (fq & 1);
        const f32x4 d0 = *(const f32x4*)(dvec + u.g * 16 + ho0), d1 = *(const f32x4*)(dvec + u.g * 16 + ho0 + 4);
        EPI_ROWS(ai, m) {
            const int chunk = u.pm * 256 + ai * 128 + wr * 64 + m * 16 + fr;
#pragma unroll
            for (int bj = 0; bj < 2; ++bj) {
                const int n0 = bj * 128 + wc * 32 + 8 * fq, j = n0 >> 4;
                const u32x4 uw = *(const u32x4*)(AC + ((size_t)(u.g * NCH + chunk) * KC + j * 16 + ho0));
                f32x4 u0, u1; unpack8(uw, u0, u1);
                f32x4 v0 = acc[ai][bj][m][0] + d0 * u0, v1 = acc[ai][bj][m][1] + d1 * u1;
#pragma unroll
                for (int q = 0; q < 4; ++q) { v0[q] = gelu_tanh(v0[q]); v1[q] = gelu_tanh(v1[q]); }
                const int token = chunk * LC + j;
                *(u32x4*)(yapre + (size_t)token * DS + u.g * 16 + ho0) = pack8(v0, v1);
            }
            EPI_FENCE(m);
        }
    }
};
struct EpiGlu {
    static constexpr bool MID = false;
    const bf16* yapre; const float* bias; bf16* Y; float* ssqa;
    __device__ __forceinline__ void mid(acc_t&, const Unit&, int, int, int, int) const {}
    __device__ __forceinline__ void operator()(const acc_t& acc, const Unit& u, int wr, int wc, int fr, int fq) const {
        asm volatile("" : "+v"(fr), "+v"(fq));
        f32x4 bv[2][2];
#pragma unroll
        for (int bj = 0; bj < 2; ++bj) { const int col = u.pn * 256 + bj * 128 + wc * 32 + 8 * fq; bv[bj][0] = *(const f32x4*)(bias + col); bv[bj][1] = *(const f32x4*)(bias + col + 4); }
        EPI_ROWS(ai, m) {
            const int row = u.pm * 256 + ai * 128 + wr * 64 + m * 16 + fr; float ss = 0.f;
#pragma unroll
            for (int bj = 0; bj < 2; ++bj) {
                const int col = u.pn * 256 + bj * 128 + wc * 32 + 8 * fq;
                f32x4 y0, y1; unpack8(*(const u32x4*)(yapre + (size_t)row * DS + col), y0, y1);
                f32x4 v0 = acc[ai][bj][m][0] + bv[bj][0], v1 = acc[ai][bj][m][1] + bv[bj][1];
#pragma unroll
                for (int q = 0; q < 4; ++q) { v0[q] = y0[q] * fast_sigmoid(v0[q]); v1[q] = y1[q] * fast_sigmoid(v1[q]); }
                ss += sumsq8(v0, v1);
                *(u32x4*)(Y + (size_t)row * D + col) = pack8(v0, v1);
            }
            ss += __shfl_xor(ss, 16); ss += __shfl_xor(ss, 32);
            if (fq == 0) ssqa[(size_t)row * 16 + u.pn * 4 + wc] = ss;
            EPI_FENCE(m);
        }
    }
};
struct EpiProj {
    static constexpr bool MID = false;
    bf16* proj;
    __device__ __forceinline__ void mid(acc_t&, const Unit&, int, int, int, int) const {}
    __device__ __forceinline__ void operator()(const acc_t& acc, const Unit& u, int wr, int wc, int fr, int fq) const {
        asm volatile("" : "+v"(fr), "+v"(fq));
        EPI_ROWS(ai, m) {
            const int row = u.pm * 256 + ai * 128 + wr * 64 + m * 16 + fr;
#pragma unroll
            for (int bj = 0; bj < 2; ++bj) { const int col = u.pn * 256 + bj * 128 + wc * 32 + 8 * fq; *(u32x4*)(proj + (size_t)row * D + col) = pack8(acc[ai][bj][m][0], acc[ai][bj][m][1]); }
        }
    }
};
struct EpiOut {
    static constexpr bool MID = true;
    const float* ssqa; const float* ssqb; const float* x; float* xo; bf16* xb; float* ssq1;
    __device__ __forceinline__ void mid(acc_t& acc, const Unit& u, int wr, int wc, int fr, int fq) const {
        asm volatile("" : "+v"(fr), "+v"(fq));
        EPI_ROWS(ai, m) {
            const int row = u.pm * 256 + ai * 128 + wr * 64 + m * 16 + fr;
            const float sa = row_partials<16>(ssqa, row, fq), sb = row_partials<8>(ssqb, row, fq);
            const float ratio = sqrtf((sb * (1.0f / 1024.0f) + EPS) / (sa * (1.0f / 1024.0f) + EPS));
#pragma unroll
            for (int bj = 0; bj < 2; ++bj) { acc[ai][bj][m][0] *= ratio; acc[ai][bj][m][1] *= ratio; }
            EPI_FENCE(m);
        }
    }
    __device__ __forceinline__ void operator()(const acc_t& acc, const Unit& u, int wr, int wc, int fr, int fq) const {
        asm volatile("" : "+v"(fr), "+v"(fq));
        EPI_ROWS(ai, m) {
            const int row = u.pm * 256 + ai * 128 + wr * 64 + m * 16 + fr;
            const float sb = row_partials<8>(ssqb, row, fq); const float rb = 1.0f / sqrtf(sb * (1.0f / 1024.0f) + EPS); float ss = 0.f;
#pragma unroll
            for (int bj = 0; bj < 2; ++bj) {
                const size_t off = (size_t)row * D + u.pn * 256 + bj * 128 + wc * 32 + 8 * fq;
                const f32x4 v0 = *(const f32x4*)(x + off) + acc[ai][bj][m][0] * rb, v1 = *(const f32x4*)(x + off + 4) + acc[ai][bj][m][1] * rb;
                *(f32x4*)(xo + off) = v0; *(f32x4*)(xo + off + 4) = v1; *(u32x4*)(xb + off) = pack8(v0, v1); ss += sumsq8(v0, v1);
            }
            ss += __shfl_xor(ss, 16); ss += __shfl_xor(ss, 32);
            if (fq == 0) ssq1[(size_t)row * 32 + u.pn * 4 + wc] = ss;
            EPI_FENCE(m);
        }
    }
};
struct EpiFfnIn {
    static constexpr bool MID = false;
    const float* ssq1; bf16* h;
    __device__ __forceinline__ void mid(acc_t&, const Unit&, int, int, int, int) const {}
    __device__ __forceinline__ void operator()(const acc_t& acc, const Unit& u, int wr, int wc, int fr, int fq) const {
        asm volatile("" : "+v"(fr), "+v"(fq));
        EPI_ROWS(ai, m) {
            const int row = u.pm * 256 + ai * 128 + wr * 64 + m * 16 + fr;
            const float r1 = 1.0f / sqrtf(row_partials<32>(ssq1, row, fq) * (1.0f / 2048.0f) + EPS);
            f32x4 g0 = acc[ai][0][m][0] * r1, g1 = acc[ai][0][m][1] * r1; const f32x4 u0 = acc[ai][1][m][0] * r1, u1 = acc[ai][1][m][1] * r1;
#pragma unroll
            for (int q = 0; q < 4; ++q) { g0[q] = silu(g0[q]) * u0[q]; g1[q] = silu(g1[q]) * u1[q]; }
            *(u32x4*)(h + (size_t)row * FF + u.pn * 128 + wc * 32 + 8 * fq) = pack8(g0, g1);
            EPI_FENCE(m);
        }
    }
};
struct EpiFfnOut {
    static constexpr bool MID = false;
    float* xo; bf16* xb; float* ssq2;
    __device__ __forceinline__ void mid(acc_t&, const Unit&, int, int, int, int) const {}
    __device__ __forceinline__ void operator()(const acc_t& acc, const Unit& u, int wr, int wc, int fr, int fq) const {
        asm volatile("" : "+v"(fr), "+v"(fq));
        EPI_ROWS(ai, m) {
            const int row = u.pm * 256 + ai * 128 + wr * 64 + m * 16 + fr; float ss = 0.f;
#pragma unroll
            for (int bj = 0; bj < 2; ++bj) {
                const size_t off = (size_t)row * D + u.pn * 256 + bj * 128 + wc * 32 + 8 * fq;
                const f32x4 v0 = *(const f32x4*)(xo + off) + acc[ai][bj][m][0], v1 = *(const f32x4*)(xo + off + 4) + acc[ai][bj][m][1];
                *(f32x4*)(xo + off) = v0; *(f32x4*)(xo + off + 4) = v1; *(u32x4*)(xb + off) = pack8(v0, v1); ss += sumsq8(v0, v1);
            }
            ss += __shfl_xor(ss, 16); ss += __shfl_xor(ss, 32);
            if (fq == 0) ssq2[(size_t)row * 32 + u.pn * 4 + wc] = ss;
            EPI_FENCE(m);
        }
    }
};
struct EpiPle {
    static constexpr bool MID = false;
    const float* ssq2; const float* bias; const bf16* proj; float* xo; float* ssq3;
    __device__ __forceinline__ void mid(acc_t&, const Unit&, int, int, int, int) const {}
    __device__ __forceinline__ void operator()(const acc_t& acc, const Unit& u, int wr, int wc, int fr, int fq) const {
        asm volatile("" : "+v"(fr), "+v"(fq));
        f32x4 bv[2][2];
#pragma unroll
        for (int bj = 0; bj < 2; ++bj) { const int col = u.pn * 256 + bj * 128 + wc * 32 + 8 * fq; bv[bj][0] = *(const f32x4*)(bias + col); bv[bj][1] = *(const f32x4*)(bias + col + 4); }
        EPI_ROWS(ai, m) {
            const int row = u.pm * 256 + ai * 128 + wr * 64 + m * 16 + fr;
            const float r2 = 1.0f / sqrtf(row_partials<32>(ssq2, row, fq) * (1.0f / 2048.0f) + EPS); float ss = 0.f;
#pragma unroll
            for (int bj = 0; bj < 2; ++bj) {
                const size_t off = (size_t)row * D + u.pn * 256 + bj * 128 + wc * 32 + 8 * fq;
                f32x4 p0, p1; unpack8(*(const u32x4*)(proj + off), p0, p1);
                f32x4 v0 = acc[ai][bj][m][0] * r2 + bv[bj][0], v1 = acc[ai][bj][m][1] * r2 + bv[bj][1];
                const f32x4 x0 = *(const f32x4*)(xo + off), x1 = *(const f32x4*)(xo + off + 4);
#pragma unroll
                for (int q = 0; q < 4; ++q) { v0[q] = x0[q] + fast_sigmoid(v0[q]) * p0[q]; v1[q] = x1[q] + fast_sigmoid(v1[q]) * p1[q]; }
                *(f32x4*)(xo + off) = v0; *(f32x4*)(xo + off + 4) = v1; ss += sumsq8(v0, v1);
            }
            ss += __shfl_xor(ss, 16); ss += __shfl_xor(ss, 32);
            if (fq == 0) ssq3[(size_t)row * 32 + u.pn * 4 + wc] = ss;
            EPI_FENCE(m);
        }
    }
};

#define XB_TMO      128
#define XB_XCNT(j)  (256  + 64 * (j))
#define XB_XSUB(j)  (1280 + 64 * (j))
#define XB_XGEN(j)  (2304 + 64 * (j))
#define XB_TOP      3328
#define XB_TOPGEN   3392
#define XCD_BAR_WORDS 3456
#define XB_SPIN_CAP (1u << 18)
__device__ __forceinline__ unsigned xb_ld(unsigned* p)              { return __hip_atomic_load(p, __ATOMIC_RELAXED, __HIP_MEMORY_SCOPE_AGENT); }
__device__ __forceinline__ unsigned xb_add(unsigned* p, unsigned v) { return __hip_atomic_fetch_add(p, v, __ATOMIC_RELAXED, __HIP_MEMORY_SCOPE_AGENT); }
__device__ __forceinline__ unsigned xb_xcc_id() { return (unsigned)__builtin_amdgcn_s_getreg((3 << 11) | 20) & 0xFu; }
#define XB_SPIN(cond, bar) do { unsigned _sp = 0; while (cond) { __builtin_amdgcn_s_sleep(1); \
    if ((++_sp & 255u) == 0u) { if (xb_ld(&(bar)[XB_TMO])) break; if (_sp > XB_SPIN_CAP) { atomicAdd(&(bar)[XB_TMO], 1u); break; } } } } while (0)
struct XcdBarrier { unsigned* bar; unsigned x; volatile LAS unsigned* st; };
__device__ __forceinline__ XcdBarrier xcd_barrier_post(unsigned* bar, volatile LAS unsigned* st) {
    XcdBarrier b; b.bar = bar; b.x = xb_xcc_id(); b.st = st;
    if (threadIdx.x == 0) (void)xb_add(&bar[XB_XCNT(b.x)], 1u);
    return b;
}
__device__ __forceinline__ void xcd_barrier_complete(unsigned* bar, unsigned x, unsigned& nloc, unsigned& nx) {
    const unsigned G = gridDim.x * gridDim.y * gridDim.z;
    unsigned sum, cnt, mine, sp = 0u;
    for (;;) {
        sum = 0u; cnt = 0u; mine = 0u;
#pragma unroll
        for (unsigned j = 0; j < 16; ++j) { const unsigned c = xb_ld(&bar[XB_XCNT(j)]); sum += c; cnt += (c > 0u) ? 1u : 0u; mine = (j == x) ? c : mine; }
        if (sum == G) break;
        __builtin_amdgcn_s_sleep(1);
        if ((++sp & 255u) == 0u) { if (xb_ld(&bar[XB_TMO])) break; if (sp > XB_SPIN_CAP) { atomicAdd(&bar[XB_TMO], 1u); break; } }
    }
    nloc = mine > 0u ? mine : 1u; nx = cnt > 0u ? cnt : 1u;
}
__device__ __forceinline__ void xcd_barrier(const XcdBarrier& b) {
    asm volatile("s_waitcnt vmcnt(0)" ::: "memory");
    __syncthreads();
    if (threadIdx.x == 0) {
        unsigned* bar = b.bar;
        __builtin_amdgcn_s_waitcnt(0);
        unsigned nloc = b.st[0], nx = b.st[1];
        if (nloc == 0u) { xcd_barrier_complete(bar, b.x, nloc, nx); b.st[0] = nloc; b.st[1] = nx; }
        const unsigned old = xb_add(&bar[XB_XSUB(b.x)], 1u);
        const unsigned gen = old / nloc;
        if (old + 1u == (gen + 1u) * nloc) {
            __builtin_amdgcn_fence(__ATOMIC_RELEASE, "agent");
            asm volatile("s_waitcnt vmcnt(0)" ::: "memory");
            const unsigned og = xb_add(&bar[XB_TOP], 1u);
            const unsigned tg = og / nx;
            if (og + 1u == (tg + 1u) * nx) xb_add(&bar[XB_TOPGEN], 1u);
            else XB_SPIN(xb_ld(&bar[XB_TOPGEN]) == tg, bar);
            __builtin_amdgcn_fence(__ATOMIC_ACQUIRE, "agent");
            xb_add(&bar[XB_XGEN(b.x)], 1u);
            asm volatile("s_waitcnt vmcnt(0)" ::: "memory");
        } else {
            XB_SPIN(xb_ld(&bar[XB_XGEN(b.x)]) == gen, bar);
            __builtin_amdgcn_fence(__ATOMIC_ACQUIRE, "agent");
            asm volatile("s_waitcnt vmcnt(0)" ::: "memory");
        }
    }
    __syncthreads();
}

struct Args { const float* in[29]; float* out; unsigned char* ws; int ph_lo, ph_hi, li, pad; };
enum In { I_X = 0, I_P, I_NMIXG, I_WIN, I_LRE, I_LIM, I_LSTEP, I_BRE, I_BIM, I_CRE, I_CIM, I_SD, I_GLUW, I_GLUB, I_LNG, I_LNB, I_SGUW, I_SGUB,
          I_ONSSM, I_ONSGU, I_WOUT, I_NFFNG, I_WFFI, I_WFFO, I_NPLEG, I_WG, I_BG, I_WPLE, I_FNG };

__device__ __forceinline__ void p0_transpose_item(const float* W, int N, const float* gain, bf16* WT, int ldt, int dst_row0, int k0, int n0, LAS float* scr, int lane) {
    float v[32];
    const float* src = W + (size_t)(k0 + (lane >> 5)) * N + n0 + (lane & 31);
#pragma unroll
    for (int i = 0; i < 32; ++i) v[i] = src[(size_t)(2 * i) * N];
    if (gain) {
#pragma unroll
        for (int i = 0; i < 32; ++i) v[i] *= gain[k0 + 2 * i + (lane >> 5)];
    }
#pragma unroll
    for (int i = 0; i < 32; ++i) scr[(2 * i + (lane >> 5)) * 33 + (lane & 31)] = v[i];
    LDS_WAIT(); asm volatile("" ::: "memory");
    const int c = lane & 7;
#pragma unroll
    for (int j = 0; j < 4; ++j) { const int n = (lane >> 3) + 8 * j; const LAS float* s = scr + (8 * c) * 33 + n;
        u32x4 o; o.x = cvt_pk_bf16(s[0 * 33], s[1 * 33]); o.y = cvt_pk_bf16(s[2 * 33], s[3 * 33]); o.z = cvt_pk_bf16(s[4 * 33], s[5 * 33]); o.w = cvt_pk_bf16(s[6 * 33], s[7 * 33]);
        *(u32x4*)(WT + (size_t)(dst_row0 + n) * ldt + k0 + 8 * c) = o; }
    LDS_WAIT(); asm volatile("" ::: "memory");
}
template <int MODE>
__device__ __forceinline__ void p0_transpose(const float* W, int K, int N, const float* gain, const float* gain2, bf16* WT, LAS float* scr, int gw, int ngw, int lane) {
    const int nblk = N / 32, nitems = (K / 64) * nblk;
    for (int it = gw; it < nitems; it += ngw) {
        const int kb = it / nblk, nb = it % nblk, k0 = 64 * kb, n0 = 32 * nb;
        int dst = n0;
        if (MODE == 1) { const int half = (n0 >= FF) ? 1 : 0, j = n0 - half * FF; dst = 256 * (j >> 7) + 128 * half + (j & 127); }
        const float* g = gain; if (gain2 && k0 >= 1024) g = gain2 - 1024;
        p0_transpose_item(W, N, g, WT, K, dst, k0, n0, scr, lane);
    }
}
__device__ __forceinline__ void p0_s5_tables(const Args& a, int g, LAS float* L, int tid) {
    LAS float* apow = L;
    LAS float* Bb = L + 2176;
    LAS float* Cc = L + 2176 + 2048;
    LAS float* Kk = L + 2176 + 4096;
    bf16* TF = (bf16*)(a.ws + WS_TF) + (size_t)g * 256 * KC;
    bf16* E = (bf16*)(a.ws + WS_E) + (size_t)g * 128 * KA;
    float* A16 = (float*)(a.ws + WS_A16) + (size_t)g * NP * 2;
    if (tid < NP) {
        const int p = tid;
        const double lr = fmin((double)a.in[I_LRE][g * NP + p], -1e-4), li = (double)a.in[I_LIM][g * NP + p];
        const double dt = exp((double)a.in[I_LSTEP][g]);
        const double mg = exp(lr * dt); double sn, cs; sincos(li * dt, &sn, &cs);
        { const double a1r = mg * cs, a1i = mg * sn; double pr = 1.0, pi = 0.0;
          for (int k = 0; k <= LC; ++k) { apow[(k * NP + p) * 2] = (float)pr; apow[(k * NP + p) * 2 + 1] = (float)pi; const double nr = pr * a1r - pi * a1i, ni = pr * a1i + pi * a1r; pr = nr; pi = ni; } }
        const double nr = mg * cs - 1.0, ni = mg * sn, den = lr * lr + li * li;
        const double qre = (nr * lr + ni * li) / den, qim = (ni * lr - nr * li) / den;
        for (int h = 0; h < NH; ++h) { const double br = (double)a.in[I_BRE][(g * NP + p) * NH + h], bi = (double)a.in[I_BIM][(g * NP + p) * NH + h];
            Bb[(p * NH + h) * 2] = (float)(qre * br - qim * bi); Bb[(p * NH + h) * 2 + 1] = (float)(qre * bi + qim * br); }
        A16[p * 2] = apow[(LC * NP + p) * 2]; A16[p * 2 + 1] = apow[(LC * NP + p) * 2 + 1];
    }
    for (int e = tid; e < NH * NP; e += 512) { Cc[e * 2] = a.in[I_CRE][g * NH * NP + e]; Cc[e * 2 + 1] = a.in[I_CIM][g * NH * NP + e]; }
    __syncthreads();
    {
        const int kh = tid >> 1, k = kh >> 4, ho = kh & 15, hi0 = 8 * (tid & 1); float s8[8];
#pragma unroll
        for (int q = 0; q < 8; ++q) s8[q] = 0.f;
#pragma unroll 4
        for (int p = 0; p < NP; ++p) {
            const f32x2 c = *(const LAS f32x2*)(Cc + (ho * NP + p) * 2), av = *(const LAS f32x2*)(apow + (k * NP + p) * 2);
            const float zr = c[0] * av[0] - c[1] * av[1], zi = c[0] * av[1] + c[1] * av[0];
#pragma unroll
            for (int q = 0; q < 8; q += 2) { const f32x4 b = *(const LAS f32x4*)(Bb + (p * NH + hi0 + q) * 2); s8[q] += zr * b[0] - zi * b[1]; s8[q + 1] += zr * b[2] - zi * b[3]; }
        }
#pragma unroll
        for (int q = 0; q < 8; ++q) Kk[kh * 16 + hi0 + q] = s8[q];
    }
    __syncthreads();
    for (int e = tid; e < 256 * 128; e += 512) {
        const int row = e >> 7, kc = (e & 127) * 2, j = row >> 4, ho = row & 15, i = kc >> 4, hi = kc & 15;
        f32x2 v = (f32x2){0.f, 0.f}; if (i <= j) v = *(const LAS f32x2*)(Kk + ((j - i) * 16 + ho) * 16 + hi);
        *(unsigned*)(TF + (size_t)row * KC + kc) = cvt_pk_bf16(v[0], v[1]);
    }
    for (int e = tid; e < 256 * 64; e += 512) {
        const int row = e >> 6, pr = e & 63, j = row >> 4, ho = row & 15, ri = pr >> 5, p = (2 * pr) & 63;
        const f32x4 c = *(const LAS f32x4*)(Cc + (ho * NP + p) * 2), av = *(const LAS f32x4*)(apow + ((j + 1) * NP + p) * 2);
        const float v0 = ri == 0 ? (c[0] * av[0] - c[1] * av[1]) : -(c[0] * av[1] + c[1] * av[0]), v1 = ri == 0 ? (c[2] * av[2] - c[3] * av[3]) : -(c[2] * av[3] + c[3] * av[2]);
        *(unsigned*)(TF + (size_t)row * KC + 256 + 2 * pr) = cvt_pk_bf16(v0, v1);
    }
    for (int e = tid; e < 128 * 128; e += 512) {
        const int row = e >> 7, kc = (e & 127) * 2, ri = row >> 6, p = row & 63, i = kc >> 4, hi = kc & 15;
        const f32x2 av = *(const LAS f32x2*)(apow + ((LC - 1 - i) * NP + p) * 2); const f32x4 b = *(const LAS f32x4*)(Bb + (p * NH + hi) * 2);
        const float v0 = ri == 0 ? (av[0] * b[0] - av[1] * b[1]) : (av[0] * b[1] + av[1] * b[0]), v1 = ri == 0 ? (av[0] * b[2] - av[1] * b[3]) : (av[0] * b[3] + av[1] * b[2]);
        *(unsigned*)(E + (size_t)row * KA + kc) = cvt_pk_bf16(v0, v1);
    }
    __syncthreads();
}

__device__ __forceinline__ void s5_scan(const Args& a, int g, int b, LAS unsigned char* lds, int wave, int lane) {
    asm volatile("" : "+v"(lane));
    const float* sloc = (const float*)(a.ws + WS_SLOC) + (size_t)(g * NCH + b * 256 + wave * 32) * 128;
    bf16* AC = (bf16*)(a.ws + WS_AC) + (size_t)(g * NCH + b * 256 + wave * 32) * KC + 256;
    const float* A16 = (const float*)(a.ws + WS_A16) + (size_t)g * NP * 2;
    const float ar = A16[lane * 2], ai = A16[lane * 2 + 1];
    float xr[32], xi[32];
#pragma unroll
    for (int j = 0; j < 32; ++j) { xr[j] = sloc[j * 128 + lane]; xi[j] = sloc[j * 128 + 64 + lane]; }
    float sr = 0.f, si = 0.f;
#pragma unroll
    for (int j = 0; j < 32; ++j) { const float nr = ar * sr - ai * si + xr[j], ni = ar * si + ai * sr + xi[j]; sr = nr; si = ni; }
    LAS float* ex = (LAS float*)lds;
    ex[(wave * 64 + lane) * 2] = sr; ex[(wave * 64 + lane) * 2 + 1] = si;
    float pr = ar, pi = ai;
#pragma unroll
    for (int q = 0; q < 5; ++q) { const float nr = pr * pr - pi * pi, ni = 2.f * pr * pi; pr = nr; pi = ni; }
    __syncthreads();
    float cr = 0.f, ci = 0.f;
    for (int v = 0; v < wave; ++v) { const float er = ex[(v * 64 + lane) * 2], ei = ex[(v * 64 + lane) * 2 + 1]; const float nr = pr * cr - pi * ci + er, ni = pr * ci + pi * cr + ei; cr = nr; ci = ni; }
    sr = cr; si = ci;
#pragma unroll
    for (int j = 0; j < 32; ++j) {
        AC[(size_t)j * KC + lane] = (bf16)(cvt_pk_bf16(sr, 0.f) & 0xffffu); AC[(size_t)j * KC + 64 + lane] = (bf16)(cvt_pk_bf16(si, 0.f) & 0xffffu);
        const float nr = ar * sr - ai * si + xr[j], ni = ar * si + ai * sr + xi[j]; sr = nr; si = ni;
    }
    VM_WAIT(); __syncthreads();
}

constexpr int SGU_LDV = 136;
__device__ __forceinline__ void sgu_unit(const Args& a, int n, int h, LAS unsigned char* lds, int tid, int wave, int lane) {
    asm volatile("" : "+v"(tid), "+v"(lane));
    LAS bf16* Vt = (LAS bf16*)lds;
    LAS float* st = (LAS float*)(lds + 36864);
    const int tok0 = n * 128, fr = lane & 15, fq = lane >> 4;
    const bf16* gv = (const bf16*)(a.ws + WS_GV); const bf16* gu = (const bf16*)(a.ws + WS_GU); bf16* Y = (bf16*)(a.ws + WS_Y);
    if (tid < 128) {
        const float* ls = (const float*)(a.ws + WS_LNST) + (size_t)(tok0 + tid) * 32; float s1 = 0.f, s2 = 0.f;
#pragma unroll
        for (int q = 0; q < 8; ++q) { const f32x4 v = *(const f32x4*)(ls + 4 * q); s1 += v[0] + v[2]; s2 += v[1] + v[3]; }
        const float mu = s1 * (1.0f / 1024.0f), var = s2 * (1.0f / 1024.0f) - mu * mu;
        st[tid * 2] = mu; st[tid * 2 + 1] = 1.0f / sqrtf(var + EPS);
    }
    __syncthreads();
#pragma unroll
    for (int i = 0; i < 4; ++i) {
        const int q = tid + 512 * i, s = q & 127, c8 = q >> 7;
        const u32x4 w = *(const u32x4*)(gv + (size_t)(tok0 + s) * DG + h * 128 + 8 * c8);
        f32x4 v0, v1; unpack8(w, v0, v1);
        const f32x4 g0 = *(const f32x4*)(a.in[I_LNG] + h * 128 + 8 * c8), g1 = *(const f32x4*)(a.in[I_LNG] + h * 128 + 8 * c8 + 4);
        const f32x4 b0 = *(const f32x4*)(a.in[I_LNB] + h * 128 + 8 * c8), b1 = *(const f32x4*)(a.in[I_LNB] + h * 128 + 8 * c8 + 4);
        const float mu = st[s * 2], rstd = st[s * 2 + 1];
        v0 = (v0 - mu) * rstd * g0 + b0; v1 = (v1 - mu) * rstd * g1 + b1;
        const unsigned p0 = cvt_pk_bf16(v0[0], v0[1]), p1 = cvt_pk_bf16(v0[2], v0[3]), p2 = cvt_pk_bf16(v1[0], v1[1]), p3 = cvt_pk_bf16(v1[2], v1[3]);
        LAS bf16* d = Vt + (8 * c8) * SGU_LDV + s;
        d[0 * SGU_LDV] = (bf16)(p0 & 0xffffu); d[1 * SGU_LDV] = (bf16)(p0 >> 16); d[2 * SGU_LDV] = (bf16)(p1 & 0xffffu); d[3 * SGU_LDV] = (bf16)(p1 >> 16);
        d[4 * SGU_LDV] = (bf16)(p2 & 0xffffu); d[5 * SGU_LDV] = (bf16)(p2 >> 16); d[6 * SGU_LDV] = (bf16)(p3 & 0xffffu); d[7 * SGU_LDV] = (bf16)(p3 >> 16);
    }
    __syncthreads();
    f32x4 acc[8];
#pragma unroll
    for (int j = 0; j < 8; ++j) acc[j] = (f32x4){0.f, 0.f, 0.f, 0.f};
    const int t = 16 * wave + fr;
    const float* wrow = a.in[I_SGUW] + ((size_t)h * 128 + t) * 128;
#pragma unroll
    for (int kk = 0; kk < 4; ++kk) {
        if (32 * kk <= 16 * wave + 15) {
            const int s0 = 32 * kk + 8 * fq;
            f32x4 w0 = *(const f32x4*)(wrow + s0), w1 = *(const f32x4*)(wrow + s0 + 4);
#pragma unroll
            for (int q = 0; q < 4; ++q) { if (s0 + q > t) w0[q] = 0.f; if (s0 + 4 + q > t) w1[q] = 0.f; }
            const u32x4 aw = pack8(w0, w1); bf16x8 af; __builtin_memcpy(&af, &aw, 16);
#pragma unroll
            for (int j = 0; j < 8; ++j) {
                const bf16x8 bfr = *(const LAS bf16x8*)(Vt + (16 * j + fr) * SGU_LDV + 32 * kk + 8 * fq);
                acc[j] = __builtin_amdgcn_mfma_f32_16x16x32_bf16(bfr, af, acc[j], 0, 0, 0);
            }
        }
    }
    const float bias = a.in[I_SGUB][h * 128 + t]; float ss = 0.f;
    const size_t tok = (size_t)(tok0 + t);
#pragma unroll
    for (int j = 0; j < 8; ++j) {
        const int c = h * 128 + 16 * j + 4 * fq;
        const u32x2 gw = *(const u32x2*)(gu + tok * DG + c);
        f32x4 o; o[0] = (acc[j][0] + bias) * bf_lo(gw.x); o[1] = (acc[j][1] + bias) * bf_hi(gw.x); o[2] = (acc[j][2] + bias) * bf_lo(gw.y); o[3] = (acc[j][3] + bias) * bf_hi(gw.y);
        ss += (o[0] * o[0] + o[1] * o[1]) + (o[2] * o[2] + o[3] * o[3]);
        u32x2 ow; ow.x = cvt_pk_bf16(o[0], o[1]); ow.y = cvt_pk_bf16(o[2], o[3]);
        *(u32x2*)(Y + tok * D + 1024 + c) = ow;
    }
    ss += __shfl_xor(ss, 16); ss += __shfl_xor(ss, 32);
    if (fq == 0) ((float*)(a.ws + WS_SSQB))[tok * 8 + h] = ss;
    __syncthreads();
}

constexpr int PER_PHASE = 10;
__global__ void __launch_bounds__(NWAVES * 64, 2) hybrid_fwd(Args args) {
    extern __shared__ __attribute__((aligned(16))) unsigned char lds_raw[];
    LAS unsigned char* lds = (LAS unsigned char*)lds_raw;
    volatile LAS unsigned* MISC = (volatile LAS unsigned*)(lds + MISC_OFF);
    const int tid = threadIdx.x, lane = tid & 63, wave = __builtin_amdgcn_readfirstlane(tid >> 6);
    const int G = gridDim.x, bx = blockIdx.x;
    const int vcu = (G % 8 == 0) ? (bx % 8) * (G / 8) + bx / 8 : bx;
    unsigned char* ws = args.ws;
    for (int u = tid; u < (LDS_BYTES - LDSCTL_OFF) / 4; u += NWAVES * 64) ((LAS unsigned*)(lds + LDSCTL_OFF))[u] = 0u;
    __syncthreads();
    XcdBarrier bar; bar.bar = (unsigned*)(ws + WS_CTL) + CW_BAR + args.li * XCD_BAR_WORDS; bar.x = 0; bar.st = nullptr;
    if (MK_N_LAUNCHES != PER_PHASE) bar = xcd_barrier_post((unsigned*)(ws + WS_CTL) + CW_BAR + args.li * XCD_BAR_WORDS, MISC + 8);
    const int lo = args.ph_lo, hi = args.ph_hi;
#ifndef PHASE_MASK
#define PHASE_MASK 0x3ff
#endif
#define IN(k) (((PHASE_MASK >> (k)) & 1) && lo <= (k) && (k) < hi)
#ifndef PROBE_PHASE
#define PROBE_PHASE (-1)
#endif
#define STAMP(k) do { if (PROBE_PHASE >= 0 && bx == 0 && tid == 0) MISC[12 + (k)] = (unsigned)__builtin_amdgcn_s_memrealtime(); } while (0)
#define STAMPX(i) do { if (PROBE_PHASE >= 100 && bx == 0 && tid == 0) MISC[24 + (i)] = (unsigned)__builtin_amdgcn_s_memrealtime(); } while (0)
#define SEAM(k) do { if (IN(k) && IN((k) + 1)) xcd_barrier(bar); STAMP((k) + 1); } while (0)
    STAMP(0);
    const int gw = vcu * NWAVES + wave, ngw = G * NWAVES;
    const bool split = (G == 256);
    const int roleA = split ? (((bx >> 3) & 1) == 0) : 1, roleB = split ? !roleA : 1;
    const int ridx = split ? (((bx >> 4) << 3) | (bx & 7)) : bx, RG = split ? 128 : G;

    bf16* WT_in = (bf16*)(ws + WS_WIN); bf16* WT_glu = (bf16*)(ws + WS_WGLU); bf16* WT_out = (bf16*)(ws + WS_WOUT); bf16* WT_ffi = (bf16*)(ws + WS_WFFI);
    bf16* WT_ffo = (bf16*)(ws + WS_WFFO); bf16* WT_g = (bf16*)(ws + WS_WG); bf16* WT_ple = (bf16*)(ws + WS_WPLE);
    bf16* XB = (bf16*)(ws + WS_XB); bf16* PB = (bf16*)(ws + WS_PB); bf16* AC = (bf16*)(ws + WS_AC);

    if (IN(0)) {
        LAS float* scr = (LAS float*)(lds + wave * 16384);
        if (bx < NG) p0_s5_tables(args, bx, (LAS float*)lds, tid);
        p0_transpose<0>(args.in[I_WIN], D, NIN, args.in[I_NMIXG], nullptr, WT_in, scr, gw, ngw, lane);
        p0_transpose<0>(args.in[I_WPLE], PLE, D, nullptr, nullptr, WT_ple, scr, gw, ngw, lane);
        float* r0 = (float*)(ws + WS_R0);
        for (int m = gw; m < T; m += ngw) {
            const f32x4* xr = (const f32x4*)(args.in[I_X] + (size_t)m * D) + lane; u32x2* o = (u32x2*)(XB + (size_t)m * D) + lane; float ss = 0.f;
#pragma unroll
            for (int j = 0; j < 8; ++j) { const f32x4 v = xr[64 * j]; ss += (v[0] * v[0] + v[1] * v[1]) + (v[2] * v[2] + v[3] * v[3]); u32x2 w; w.x = cvt_pk_bf16(v[0], v[1]); w.y = cvt_pk_bf16(v[2], v[3]); o[64 * j] = w; }
            ss = wave_sum(ss);
            if (lane == 0) r0[m] = 1.0f / sqrtf(ss * (1.0f / 2048.0f) + EPS);
        }
        for (int e = gw * 64 + lane; e < T * PLE / 8; e += ngw * 64) { const f32x4 v0 = *((const f32x4*)args.in[I_P] + 2 * e), v1 = *((const f32x4*)args.in[I_P] + 2 * e + 1); *((u32x4*)PB + e) = pack8(v0, v1); }
    }
    SEAM(0);
    if (IN(1)) {
        pg8::SchedTiles S; S.init(XB, WT_in + (size_t)DS * D, T, 2 * DG, D, D, G, bx, 4);
        EpiIn E{(const float*)(ws + WS_R0), AC, (bf16*)(ws + WS_GU), (bf16*)(ws + WS_GV), (float*)(ws + WS_LNST)};
        pg8::gemm_phase<EpiIn, pg8::SchedTiles, true>(lds, D, D, D, S, E, tid);
    }
    SEAM(1);
    if (IN(2)) {
        if (roleA) {
            pg8::SchedTiles S; S.init(XB, WT_in, T, DS, D, D, RG, ridx, 0);
            EpiIn E{(const float*)(ws + WS_R0), AC, (bf16*)(ws + WS_GU), (bf16*)(ws + WS_GV), (float*)(ws + WS_LNST)};
            pg8::gemm_phase<EpiIn, pg8::SchedTiles, true>(lds, D, D, D, S, E, tid);
        }
        if (roleB) {
            for (int un = ridx; un < 512; un += RG) sgu_unit(args, un >> 3, un & 7, lds, tid, wave, lane);
        }
    }
    SEAM(2);
    if (IN(3)) {
        if (roleA) {
            for (int un = ridx; un < 2 * NG; un += RG) {
                const int g = un >> 1, b = un & 1;
                pg8::SchedOne S; S.u.A = (const char*)(AC + (size_t)(g * NCH + b * 256) * KC); S.u.pm = b; S.u.pn = 0; S.u.g = g;
                S.u.B = (const char*)((const bf16*)(ws + WS_E) + (size_t)g * 128 * KA);
                EpiSloc E1{(float*)(ws + WS_SLOC)};
                pg8::gemm_phase<EpiSloc, pg8::SchedOne, false>(lds, KA, KC, KA, S, E1, tid);
                VM_WAIT(); __syncthreads();
                s5_scan(args, g, b, lds, wave, lane);
                S.u.B = (const char*)((const bf16*)(ws + WS_TF) + (size_t)g * 256 * KC);
                EpiS5Out E2{AC, args.in[I_SD], (bf16*)(ws + WS_YAPRE)};
                pg8::gemm_phase<EpiS5Out, pg8::SchedOne, false>(lds, KC, KC, KC, S, E2, tid);
                __syncthreads();
            }
        }
        if (roleB) {
            pg8::SchedTiles S; S.init(PB, WT_ple, T, D, PLE, PLE, RG, ridx);
            EpiProj E{(bf16*)(ws + WS_PROJ)};
            pg8::gemm_phase<EpiProj, pg8::SchedTiles, true>(lds, PLE, PLE, PLE, S, E, tid);
            LAS float* scr = (LAS float*)(lds + wave * 16384);
            p0_transpose<0>(args.in[I_GLUW], DS, DS, nullptr, nullptr, WT_glu, scr, ridx * NWAVES + wave, RG * NWAVES, lane);
            p0_transpose<0>(args.in[I_WOUT], D, D, args.in[I_ONSSM], args.in[I_ONSGU], WT_out, scr, ridx * NWAVES + wave, RG * NWAVES, lane);
        }
    }
    SEAM(3);
    if (IN(4)) {
        if (roleA) {
            pg8::SchedTiles S; S.init((const bf16*)(ws + WS_YAPRE), WT_glu, T, DS, DS, DS, RG, ridx);
            EpiGlu E{(const bf16*)(ws + WS_YAPRE), args.in[I_GLUB], (bf16*)(ws + WS_Y), (float*)(ws + WS_SSQA)};
            pg8::gemm_phase<EpiGlu, pg8::SchedTiles, true>(lds, DS, DS, DS, S, E, tid);
        }
        if (roleB) p0_transpose<1>(args.in[I_WFFI], D, 2 * FF, args.in[I_NFFNG], nullptr, WT_ffi, (LAS float*)(lds + wave * 16384), ridx * NWAVES + wave, RG * NWAVES, lane);
    }
    SEAM(4);
    if (IN(5)) {
        pg8::SchedTiles S; S.init((const bf16*)(ws + WS_Y), WT_out, T, D, D, D, G, bx);
        EpiOut E{(const float*)(ws + WS_SSQA), (const float*)(ws + WS_SSQB), args.in[I_X], args.out, XB, (float*)(ws + WS_SSQ1)};
        pg8::gemm_phase<EpiOut, pg8::SchedTiles, true>(lds, D, D, D, S, E, tid);
    }
    SEAM(5);
    if (IN(6)) {
        pg8::SchedTiles S; S.init(XB, WT_ffi, T, 2 * FF, D, D, G, bx);
        EpiFfnIn E{(const float*)(ws + WS_SSQ1), (bf16*)(ws + WS_H)};
        pg8::gemm_phase<EpiFfnIn, pg8::SchedTiles, true>(lds, D, D, D, S, E, tid);
        { const int ntile = (T / 256) * (2 * FF / 256), nfull = ntile % G; LAS float* scr = (LAS float*)(lds + wave * 16384);
          const int cgw = (nfull == 0) ? gw : (bx - nfull) * NWAVES + wave, cngw = (nfull == 0) ? ngw : (G - nfull) * NWAVES;
          if (nfull == 0 || bx >= nfull) {
              p0_transpose<0>(args.in[I_WFFO], FF, D, nullptr, nullptr, WT_ffo, scr, cgw, cngw, lane);
              p0_transpose<0>(args.in[I_WG], D, D, args.in[I_NPLEG], nullptr, WT_g, scr, cgw, cngw, lane); } }
    }
    SEAM(6);
    if (IN(7)) {
        pg8::SchedTiles S; S.init((const bf16*)(ws + WS_H), WT_ffo, T, D, FF, FF, G, bx);
        EpiFfnOut E{args.out, XB, (float*)(ws + WS_SSQ2)};
        pg8::gemm_phase<EpiFfnOut, pg8::SchedTiles, true>(lds, FF, FF, FF, S, E, tid);
    }
    SEAM(7);
    if (IN(8)) {
        pg8::SchedTiles S; S.init(XB, WT_g, T, D, D, D, G, bx);
        EpiPle E{(const float*)(ws + WS_SSQ2), args.in[I_BG], (const bf16*)(ws + WS_PROJ), args.out, (float*)(ws + WS_SSQ3)};
        pg8::gemm_phase<EpiPle, pg8::SchedTiles, true>(lds, D, D, D, S, E, tid);
    }
    SEAM(8);
    if (IN(9)) {
        const float* ssq3 = (const float*)(ws + WS_SSQ3);
        for (int m = gw; m < T; m += ngw) {
            float s = (lane < 32) ? ssq3[(size_t)m * 32 + lane] : 0.f; s = wave_sum(s);
            const float r = 1.0f / sqrtf(s * (1.0f / 2048.0f) + EPS);
            f32x4* xr = (f32x4*)(args.out + (size_t)m * D) + lane; const f32x4* gr = (const f32x4*)args.in[I_FNG] + lane;
#pragma unroll
            for (int j = 0; j < 8; ++j) { const f32x4 v = xr[64 * j] * r * gr[64 * j]; xr[64 * j] = v; }
        }
    }
    STAMP(10);
    if (PROBE_PHASE >= 0 && bx == 0 && tid == 0) {
        const unsigned span = (PROBE_PHASE >= 100) ? MISC[24 + PROBE_PHASE - 100 + 1] - MISC[24 + PROBE_PHASE - 100] : MISC[12 + PROBE_PHASE + 1] - MISC[12 + PROBE_PHASE], t9 = MISC[12 + 10];
        while ((unsigned)__builtin_amdgcn_s_memrealtime() - t9 < span) __builtin_amdgcn_s_sleep(8);
    }
#undef IN
#undef SEAM
}

extern "C" void kernel_launch(void* const* d_in, const int* in_sizes, int n_in, void* d_out, int out_size, void* d_ws, size_t ws_size, hipStream_t stream) {
    static int grid = 0;
    if (grid == 0) {
        if (n_in != 29 || in_sizes[0] != T * D || out_size != T * D || ws_size < WS_END) {
            fprintf(stderr, "kernel_launch: shape/workspace mismatch: n_in %d in0 %d out %d ws %zu (need %zu); nothing launched\n", n_in, n_in > 0 ? in_sizes[0] : -1, out_size, ws_size, (size_t)WS_END); grid = -1; return; }
        int dev = 0, cus = 0, per_cu = 0;
        if (hipGetDevice(&dev) != hipSuccess || hipDeviceGetAttribute(&cus, hipDeviceAttributeMultiprocessorCount, dev) != hipSuccess) { fprintf(stderr, "kernel_launch: device query failed\n"); grid = -1; return; }
        if (hipFuncSetAttribute((const void*)hybrid_fwd, hipFuncAttributeMaxDynamicSharedMemorySize, LDS_BYTES) != hipSuccess) { fprintf(stderr, "kernel_launch: hipFuncSetAttribute failed\n"); grid = -1; return; }
        if (hipOccupancyMaxActiveBlocksPerMultiprocessor(&per_cu, (const void*)hybrid_fwd, NWAVES * 64, LDS_BYTES) != hipSuccess || per_cu < 1) { fprintf(stderr, "kernel_launch: occupancy query says %d blocks per CU; nothing launched\n", per_cu); (void)hipGetLastError(); grid = -1; return; }
        grid = cus;
        fprintf(stderr, "kernel_launch: grid %d (CUs %d, occupancy %d/CU), ws need %zu have %zu\n", grid, cus, per_cu, (size_t)WS_END, ws_size);
    }
    if (grid < 0) return;
    if (hipMemsetAsync((char*)d_ws + WS_CTL, 0, CTL_ZERO_BYTES, stream) != hipSuccess) { fprintf(stderr, "kernel_launch: memset failed\n"); return; }
    Args a{};
    for (int i = 0; i < 29; ++i) a.in[i] = (const float*)d_in[i];
    a.out = (float*)d_out; a.ws = (unsigned char*)d_ws;
    if (MK_N_LAUNCHES == 1) {
        a.ph_lo = 0; a.ph_hi = PER_PHASE; a.li = 0;
        void* kargs[] = {&a};
#ifdef PLAIN_LAUNCH
        (void)kargs; hipLaunchKernelGGL(hybrid_fwd, dim3(grid), dim3(NWAVES * 64), LDS_BYTES, stream, a);
        const hipError_t le = hipPeekAtLastError();
#else
        const hipError_t le = hipLaunchCooperativeKernel((const void*)hybrid_fwd, dim3(grid), dim3(NWAVES * 64), kargs, LDS_BYTES, stream);
#endif
        if (le != hipSuccess) fprintf(stderr, "kernel_launch: launch failed: %s (grid %d)\n", hipGetErrorName(le), grid);
    } else {
        for (int li = 0; li < PER_PHASE; ++li) {
            a.ph_lo = li; a.ph_hi = li + 1; a.li = 0;
            hipLaunchKernelGGL(hybrid_fwd, dim3(grid), dim3(NWAVES * 64), LDS_BYTES, stream, a);
            const hipError_t le = hipPeekAtLastError();
            if (le != hipSuccess) { fprintf(stderr, "kernel_launch: launch %d failed: %s\n", li, hipGetErrorName(le)); break; }
        }
    }
}
```

```cpp
#include <hip/hip_runtime.h>
#include <cstdio>
#include <cstdint>

#ifndef MK_N_LAUNCHES
#define MK_N_LAUNCHES 1
#endif

#define LAS __attribute__((address_space(3)))
#define GAS __attribute__((address_space(1)))
typedef unsigned short bf16;
typedef short bf16x8 __attribute__((ext_vector_type(8)));
typedef float f32x4 __attribute__((ext_vector_type(4)));
typedef float f32x2 __attribute__((ext_vector_type(2)));
typedef unsigned u32x4 __attribute__((ext_vector_type(4)));
typedef unsigned u32x2 __attribute__((ext_vector_type(2)));
typedef GAS unsigned gu32;

constexpr int T = 8192;
constexpr int SEQ = 4096;
constexpr int D = 2048, DS = 1024, DG = 1024, NIN = 3072, FF = 5632, PLE = 256;
constexpr int NG = 64, NP = 64, NH = 16;
constexpr int LC = 16;
constexpr int NCH = T / LC;
constexpr int KC = LC * NH + 2 * NP;
constexpr int KA = LC * NH;
constexpr float EPS = 1e-6f;

constexpr size_t MiB = 1u << 20;
constexpr size_t WS_CTL = 0, CTL_ZERO_BYTES = 64 * 1024;
constexpr size_t WS_WFFI = 1 * MiB;
constexpr size_t WS_WFFO = WS_WFFI + 44 * MiB;
constexpr size_t WS_WG   = WS_WFFO + 22 * MiB;
constexpr size_t WS_WPLE = WS_WG + 8 * MiB;
constexpr size_t WS_XB   = WS_WPLE + 1 * MiB;
constexpr size_t WS_PROJ = WS_XB + 32 * MiB;
constexpr size_t WS_SSQA = WS_PROJ + 32 * MiB;
constexpr size_t WS_SSQB = WS_SSQA + 1 * MiB;
constexpr size_t WS_SSQ1 = WS_SSQB + 1 * MiB;
constexpr size_t WS_SSQ2 = WS_SSQ1 + 1 * MiB;
constexpr size_t WS_SSQ3 = WS_SSQ2 + 1 * MiB;
constexpr size_t WS_LNST = WS_SSQ3 + 1 * MiB;
constexpr size_t WS_R0   = WS_LNST + 1 * MiB;
constexpr size_t WS_EARLY = WS_R0 + 1 * MiB;
constexpr size_t WS_WIN  = WS_EARLY;
constexpr size_t WS_WGLU = WS_WIN + 12 * MiB;
constexpr size_t WS_WOUT = WS_WGLU + 2 * MiB;
constexpr size_t WS_TF   = WS_WOUT + 8 * MiB;
constexpr size_t WS_E    = WS_TF + 12 * MiB;
constexpr size_t WS_A16  = WS_E + 5 * MiB;
constexpr size_t WS_AC   = WS_A16 + 1 * MiB;
constexpr size_t WS_GU   = WS_AC + 24 * MiB;
constexpr size_t WS_GV   = WS_GU + 16 * MiB;
constexpr size_t WS_SLOC = WS_GV + 16 * MiB;
constexpr size_t WS_YAPRE = WS_SLOC + 16 * MiB;
constexpr size_t WS_Y    = WS_YAPRE + 16 * MiB;
constexpr size_t WS_PB   = WS_Y + 32 * MiB;
constexpr size_t WS_EARLY_END = WS_PB + 4 * MiB;
constexpr size_t WS_H    = WS_EARLY;
constexpr size_t WS_END  = (WS_EARLY_END > WS_H + 88 * MiB) ? WS_EARLY_END : WS_H + 88 * MiB;

constexpr int CW_BAR = 4096;

constexpr int RING_BYTES = 131072;
constexpr int LDSCTL_OFF = RING_BYTES, MISC_OFF = LDSCTL_OFF + 320;
constexpr int LDS_BYTES = 147456;
constexpr int NWAVES = 8;

#define RLX_AGENT __ATOMIC_RELAXED, __HIP_MEMORY_SCOPE_AGENT
#define LDS_WAIT() asm volatile("s_waitcnt lgkmcnt(0)" ::: "memory")
#define VM_WAIT() asm volatile("s_waitcnt vmcnt(0)" ::: "memory")
__device__ __forceinline__ unsigned cvt_pk_bf16(float lo, float hi) { unsigned r; asm volatile("v_cvt_pk_bf16_f32 %0, %1, %2" : "=v"(r) : "v"(lo), "v"(hi)); return r; }
__device__ __forceinline__ float bf_lo(unsigned w) { return __uint_as_float(w << 16); }
__device__ __forceinline__ float bf_hi(unsigned w) { return __uint_as_float(w & 0xffff0000u); }
__device__ __forceinline__ float fast_sigmoid(float y) { return __builtin_amdgcn_rcpf(1.0f + __builtin_amdgcn_exp2f(-1.4426950408889634f * y)); }
__device__ __forceinline__ float gelu_tanh(float x) { const float y = 1.5957691216057308f * (x + 0.044715f * x * x * x); return x * fast_sigmoid(y); }
__device__ __forceinline__ float silu(float x) { return x * fast_sigmoid(x); }
__device__ __forceinline__ float wave_sum(float v) {
#pragma unroll
    for (int o = 1; o < 64; o <<= 1) v += __shfl_xor(v, o);
    return v;
}

namespace pg8 {
constexpr int BM = 256, BK = 64, HALF = 128, HTB = HALF * BK * 2, NXCD = 8, WGM = 8;
__host__ __device__ __forceinline__ int lds_byte(int r, int c) { const int st = (r >> 4) * 2 + (c >> 5), rr = r & 15, cc = c & 31, ob = rr * 64 + cc * 2; return st * 1024 + (ob ^ (((ob >> 9) & 1) << 5)); }
__host__ __device__ __forceinline__ void stage_rc(int b, int& R, int& C) { const int st = b / 1024, sb = b % 1024, swz = sb ^ (((sb >> 9) & 1) << 5); R = (st >> 1) * 16 + swz / 64; C = (st & 1) * 32 + (swz % 64) / 2; }
__host__ __device__ __forceinline__ int perm32(int rho) { const int n = rho >> 4, i = rho & 15; return 8 * (i >> 2) + 4 * n + (i & 3); }

struct Unit { const char* A; const char* B; int pm, pn, g; };

struct SchedTiles {
    const char* A; const char* B; size_t tstepA, tstepB; int nM, nN, nwg, G, c, pn0;
    __device__ __forceinline__ void init(const void* A_, const void* B_, int M, int N, int lda, int ldb, int G_, int c_, int pn0_ = 0) {
        pn0 = pn0_; A = (const char*)A_; B = (const char*)B_; tstepA = (size_t)BM * lda * 2; tstepB = (size_t)BM * ldb * 2; nM = M / BM; nN = N / BM; nwg = nM * nN; G = G_; c = c_; }
    __device__ __forceinline__ bool next(int i, Unit& u) const {
        const int L = i * G + c; if (L >= nwg) return false;
        int wgid = L; { const int q = nwg / NXCD, r = nwg % NXCD, xcd = wgid % NXCD, off = wgid / NXCD; wgid = (xcd < r ? xcd * (q + 1) : r * (q + 1) + (xcd - r) * q) + off; }
        const int nig = WGM * nN, gid = wgid / nig, fm = gid * WGM, gsz = (nM - fm) < WGM ? (nM - fm) : WGM;
        u.pm = fm + ((wgid % nig) % gsz); u.pn = (wgid % nig) / gsz; u.g = 0;
        u.A = A + (size_t)u.pm * tstepA; u.B = B + (size_t)u.pn * tstepB; u.pn += pn0; return true;
    }
};
struct SchedOne { Unit u; __device__ __forceinline__ bool next(int i, Unit& o) const { if (i != 0) return false; o = u; return true; } };

template <class Epi, class Sched, bool ALIGN_EPI>
__device__ __forceinline__ void gemm_phase(LAS unsigned char* lds, const int K, const int lda, const int ldb, const Sched& S, const Epi& E, int tid) {
    asm volatile("" : "+v"(tid));
    const int wid = __builtin_amdgcn_readfirstlane(tid >> 6), lane = tid & 63, wr = wid >> 2, wc = wid & 3, fr = lane & 15, fq = lane >> 4;
    const int nt = K / BK;
    unsigned voffA[2], voffB[2];
#pragma unroll
    for (int i = 0; i < 2; ++i) { int R, C; stage_rc(tid * 16 + i * 8192, R, C); const int Rb = (R & ~31) + perm32(R & 31);
        voffA[i] = (unsigned)(R * lda + C) * 2u; voffB[i] = (unsigned)(Rb * ldb + C) * 2u; }
    const size_t kstep = (size_t)(BK * 2);
    const size_t hstepA = (size_t)HALF * lda * 2, hstepB = (size_t)HALF * ldb * 2;
    const unsigned ldsw = (unsigned)wid * 1024u;
    const int aoff = lds_byte(wr * 64 + fr, fq * 8), boff = lds_byte(wc * 32 + fr, fq * 8);
#define PG8_SA(b, h) (((b) * 2 + (h)) * HTB)
#define PG8_SB(b, h) ((4 + (b) * 2 + (h)) * HTB)
#define PG8_STAGE(bufoff, gbase, voff) do { _Pragma("unroll") for (int _i = 0; _i < 2; ++_i) \
        __builtin_amdgcn_global_load_lds((const unsigned*)((const char*)(gbase) + (voff)[_i]), (LAS unsigned*)(lds + (bufoff) + ldsw + _i * 8192), 16, 0, 0); } while (0)
#define PG8_LDA(dst, b, h) do { _Pragma("unroll") for (int m = 0; m < 4; ++m) _Pragma("unroll") for (int k = 0; k < 2; ++k) dst[m][k] = *(const LAS bf16x8*)(lds + PG8_SA(b, h) + aoff + m * 2048 + k * 1024); } while (0)
#define PG8_LDB(dst, b, h) do { _Pragma("unroll") for (int n = 0; n < 2; ++n) _Pragma("unroll") for (int k = 0; k < 2; ++k) dst[n][k] = *(const LAS bf16x8*)(lds + PG8_SB(b, h) + boff + n * 2048 + k * 1024); } while (0)
#define PG8_MMA(ai, bj, At, Bt) do { __builtin_amdgcn_s_setprio(1); _Pragma("unroll") for (int m = 0; m < 4; ++m) _Pragma("unroll") for (int n = 0; n < 2; ++n) _Pragma("unroll") for (int k = 0; k < 2; ++k) \
        acc[ai][bj][m][n] = __builtin_amdgcn_mfma_f32_16x16x32_bf16(Bt[n][k], At[m][k], acc[ai][bj][m][n], 0, 0, 0); __builtin_amdgcn_s_setprio(0); } while (0)
#define PG8_WAIT_V(n) asm volatile("s_waitcnt vmcnt(" #n ")" ::: "memory")
#define PG8_WAIT_L(n) asm volatile("s_waitcnt lgkmcnt(" #n ")" ::: "memory")
#define PG8_BAR __builtin_amdgcn_s_barrier()
#define PG8_SCHED __builtin_amdgcn_sched_barrier(0)
    Unit cur, nxt; int ui = 0;
    if (!S.next(0, cur)) return;
    f32x4 acc[2][2][4][2];
#pragma unroll
    for (int a = 0; a < 2; ++a)
#pragma unroll
        for (int b = 0; b < 2; ++b)
#pragma unroll
            for (int m = 0; m < 4; ++m)
#pragma unroll
                for (int n = 0; n < 2; ++n) acc[a][b][m][n] = (f32x4){0.f, 0.f, 0.f, 0.f};
    bf16x8 At[4][2], B0[2][2], B1[2][2];
    const char* cA = cur.A; const char* cB = cur.B;
    PG8_STAGE(PG8_SB(0, 0), cB, voffB); PG8_STAGE(PG8_SB(0, 1), cB + hstepB, voffB); PG8_STAGE(PG8_SA(0, 0), cA, voffA); PG8_STAGE(PG8_SA(0, 1), cA + hstepA, voffA);
    if (wr == 1) PG8_BAR;
    PG8_WAIT_V(2); PG8_BAR;
    PG8_STAGE(PG8_SB(1, 0), cB + kstep, voffB); PG8_STAGE(PG8_SA(1, 0), cA + kstep, voffA); PG8_STAGE(PG8_SB(1, 1), cB + hstepB + kstep, voffB);
    PG8_WAIT_V(6); PG8_BAR;
    for (;;) {
        const bool has_next = S.next(ui + 1, nxt);
        const char* nA = has_next ? nxt.A : cA; const char* nB = has_next ? nxt.B : cB;
        for (int t = 0; t < nt; t += 2) {
            const bool last = (t == nt - 2);
            const char* a1 = cA + (size_t)(t + 1) * kstep;
            const char* a2 = last ? nA : cA + (size_t)(t + 2) * kstep; const char* b2 = last ? nB : cB + (size_t)(t + 2) * kstep;
            const char* a3 = a2 + kstep; const char* b3 = b2 + kstep;
            if constexpr (Epi::MID) { if (t == (nt >> 1)) E.mid(acc, cur, wr, wc, fr, fq); }
            PG8_LDB(B0, 0, 0); PG8_LDB(B1, 0, 1); PG8_SCHED; PG8_LDA(At, 0, 0); PG8_STAGE(PG8_SA(1, 1), a1 + hstepA, voffA);
            PG8_WAIT_V(8); PG8_WAIT_L(0); PG8_BAR; PG8_MMA(0, 0, At, B0); PG8_MMA(0, 1, At, B1); PG8_BAR; PG8_SCHED;
            PG8_LDA(At, 0, 1); PG8_STAGE(PG8_SB(0, 0), b2, voffB); PG8_STAGE(PG8_SB(0, 1), b2 + hstepB, voffB); PG8_STAGE(PG8_SA(0, 0), a2, voffA);
            PG8_WAIT_V(8); PG8_WAIT_L(0); PG8_BAR; PG8_MMA(1, 0, At, B0); PG8_MMA(1, 1, At, B1); PG8_BAR; PG8_SCHED;
            PG8_LDB(B0, 1, 0); PG8_LDB(B1, 1, 1); PG8_SCHED; PG8_LDA(At, 1, 0); PG8_STAGE(PG8_SA(0, 1), a2 + hstepA, voffA);
            PG8_WAIT_V(8); PG8_WAIT_L(0); PG8_BAR; PG8_MMA(0, 0, At, B0); PG8_MMA(0, 1, At, B1); PG8_BAR; PG8_SCHED;
            PG8_LDA(At, 1, 1); PG8_STAGE(PG8_SB(1, 0), b3, voffB); PG8_STAGE(PG8_SB(1, 1), b3 + hstepB, voffB); PG8_STAGE(PG8_SA(1, 0), a3, voffA);
            PG8_WAIT_V(8); PG8_WAIT_L(0); PG8_BAR; PG8_MMA(1, 0, At, B0); PG8_MMA(1, 1, At, B1); PG8_BAR; PG8_SCHED;
        }
        if constexpr (ALIGN_EPI) { if (wr == 0) PG8_BAR; }
        E(acc, cur, wr, wc, fr, fq);
        if (!has_next) break;
#pragma unroll
        for (int a = 0; a < 2; ++a)
#pragma unroll
            for (int b = 0; b < 2; ++b)
#pragma unroll
                for (int m = 0; m < 4; ++m)
#pragma unroll
                    for (int n = 0; n < 2; ++n) acc[a][b][m][n] = (f32x4){0.f, 0.f, 0.f, 0.f};
        cur = nxt; cA = nA; cB = nB; ++ui;
        if constexpr (ALIGN_EPI) { if (wr == 1) PG8_BAR; }
    }
    PG8_WAIT_V(0);
    if constexpr (!ALIGN_EPI) { if (wr == 0) PG8_BAR; }
    PG8_BAR;
#undef PG8_SA
#undef PG8_SB
#undef PG8_STAGE
#undef PG8_LDA
#undef PG8_LDB
#undef PG8_MMA
#undef PG8_WAIT_V
#undef PG8_WAIT_L
#undef PG8_BAR
#undef PG8_SCHED
}
}
using pg8::Unit;

#define EPI_ROWS(ai, m) _Pragma("unroll") for (int ai = 0; ai < 2; ++ai) _Pragma("unroll") for (int m = 0; m < 4; ++m)
typedef f32x4 acc_t[2][2][4][2];
#define EPI_FENCE(m) do { if ((m) & 1) asm volatile("" ::: "memory"); } while (0)

__device__ __forceinline__ u32x4 pack8(f32x4 v0, f32x4 v1) { u32x4 w; w.x = cvt_pk_bf16(v0[0], v0[1]); w.y = cvt_pk_bf16(v0[2], v0[3]); w.z = cvt_pk_bf16(v1[0], v1[1]); w.w = cvt_pk_bf16(v1[2], v1[3]); return w; }
__device__ __forceinline__ float sumsq8(f32x4 a, f32x4 b) { return ((a[0] * a[0] + a[1] * a[1]) + (a[2] * a[2] + a[3] * a[3])) + ((b[0] * b[0] + b[1] * b[1]) + (b[2] * b[2] + b[3] * b[3])); }
__device__ __forceinline__ float sum8(f32x4 a, f32x4 b) { return ((a[0] + a[1]) + (a[2] + a[3])) + ((b[0] + b[1]) + (b[2] + b[3])); }
__device__ __forceinline__ void unpack8(u32x4 w, f32x4& a, f32x4& b) { a = (f32x4){bf_lo(w.x), bf_hi(w.x), bf_lo(w.y), bf_hi(w.y)}; b = (f32x4){bf_lo(w.z), bf_hi(w.z), bf_lo(w.w), bf_hi(w.w)}; }
template <int NPART> __device__ __forceinline__ float row_partials(const float* base, int row, int fq) {
    float s;
    if constexpr (NPART == 32) { const f32x4 a = *(const f32x4*)(base + (size_t)row * 32 + 8 * fq), b = *(const f32x4*)(base + (size_t)row * 32 + 8 * fq + 4); s = sum8(a, b); }
    else if constexpr (NPART == 16) { const f32x4 a = *(const f32x4*)(base + (size_t)row * 16 + 4 * fq); s = (a[0] + a[1]) + (a[2] + a[3]); }
    else { const f32x2 a = *(const f32x2*)(base + (size_t)row * 8 + 2 * fq); s = a[0] + a[1]; }
    s += __shfl_xor(s, 16); s += __shfl_xor(s, 32); return s;
}

template <class Tv> __device__ __forceinline__ Tv ldg(const void* ubase, unsigned voff) { return *(const Tv*)((const char*)ubase + voff); }
template <class Tv> __device__ __forceinline__ void stg(void* ubase, unsigned voff, Tv v) { *(Tv*)((char*)ubase + voff) = v; }
template <int NPART> __device__ __forceinline__ float row_part2(const float* rbase, unsigned vo) {
    float s;
    if constexpr (NPART == 32) { const f32x4 a = ldg<f32x4>(rbase, vo), b = ldg<f32x4>(rbase, vo + 16); s = sum8(a, b); }
    else if constexpr (NPART == 16) { const f32x4 a = ldg<f32x4>(rbase, vo); s = (a[0] + a[1]) + (a[2] + a[3]); }
    else { const f32x2 a = ldg<f32x2>(rbase, vo); s = a[0] + a[1]; }
    s += __shfl_xor(s, 16); s += __shfl_xor(s, 32); return s;
}
struct EpiIn {
    static constexpr bool MID = false;
    const float* r0; bf16* AC; bf16* gu; bf16* gv; float* lnst;
    __device__ __forceinline__ void mid(acc_t&, const Unit&, int, int, int, int) const {}
    __device__ __forceinline__ void operator()(const acc_t& acc, const Unit& u, int wr, int wc, int fr, int fq) const {
        asm volatile("" : "+v"(fr), "+v"(fq));
        const int sect = u.pn >> 2;
        EPI_ROWS(ai, m) {
            const int row = u.pm * 256 + ai * 128 + wr * 64 + m * 16 + fr; const float rs = r0[row];
            float s1 = 0.f, s2 = 0.f;
#pragma unroll
            for (int bj = 0; bj < 2; ++bj) {
                const int col = u.pn * 256 + bj * 128 + wc * 32 + 8 * fq;
                f32x4 v0 = acc[ai][bj][m][0] * rs, v1 = acc[ai][bj][m][1] * rs;
                if (sect == 0) {
                    const int g = col >> 4, hi0 = col & 15, chunk = row >> 4, i = row & 15;
                    *(u32x4*)(AC + ((size_t)(g * NCH + chunk) * KC + i * 16 + hi0)) = pack8(v0, v1);
                } else {
#pragma unroll
                    for (int j = 0; j < 4; ++j) { v0[j] = gelu_tanh(v0[j]); v1[j] = gelu_tanh(v1[j]); }
                    if (sect == 1) *(u32x4*)(gu + (size_t)row * DG + (col - 1024)) = pack8(v0, v1);
                    else { *(u32x4*)(gv + (size_t)row * DG + (col - 2048)) = pack8(v0, v1); s1 += sum8(v0, v1); s2 += sumsq8(v0, v1); }
                }
            }
            if (sect == 2) {
                s1 += __shfl_xor(s1, 16); s1 += __shfl_xor(s1, 32); s2 += __shfl_xor(s2, 16); s2 += __shfl_xor(s2, 32);
                if (fq == 0) *(f32x2*)(lnst + ((size_t)row * 16 + (u.pn - 8) * 4 + wc) * 2) = (f32x2){s1, s2};
            }
        }
    }
};
struct EpiSloc {
    static constexpr bool MID = false;
    float* sloc;
    __device__ __forceinline__ void mid(acc_t&, const Unit&, int, int, int, int) const {}
    __device__ __forceinline__ void operator()(const acc_t& acc, const Unit& u, int wr, int wc, int fr, int fq) const {
        asm volatile("" : "+v"(fr), "+v"(fq));
        EPI_ROWS(ai, m) {
            const int row = u.pm * 256 + ai * 128 + wr * 64 + m * 16 + fr;
            float* o = sloc + ((size_t)(u.g * NCH + row) * 128 + wc * 32 + 8 * fq);
            *(f32x4*)o = acc[ai][0][m][0]; *(f32x4*)(o + 4) = acc[ai][0][m][1];
        }
    }
};
struct EpiS5Out {
    static constexpr bool MID = false;
    const bf16* AC; const float* dvec; bf16* yapre;
    __device__ __forceinline__ void mid(acc_t&, const Unit&, int, int, int, int) const {}
    __device__ __forceinline__ void operator()(const acc_t& acc, const Unit& u, int wr, int wc, int fr, int fq) const {
        asm volatile("" : "+v"(fr), "+v"(fq));
        const int ho0 = 8 * (fq & 1);
        const f32x4 d0 = *(const f32x4*)(dvec + u.g * 16 + ho0), d1 = *(const f32x4*)(dvec + u.g * 16 + ho0 + 4);
        const unsigned vin = (unsigned)(((wr * 64 + fr) * KC + (2 * wc + (fq >> 1)) * 16 + ho0) * 2);
        const unsigned vout = (unsigned)((((wr * 64 + fr) * LC + 2 * wc + (fq >> 1)) * DS + ho0) * 2);
        const bf16* ib = AC + (size_t)(u.g * NCH + u.pm * 256) * KC; bf16* ob = yapre + (size_t)u.pm * 256 * LC * DS + u.g * 16;
        u32x4 uw[2][4][2];
        EPI_ROWS(ai, m) {
#pragma unroll
            for (int bj = 0; bj < 2; ++bj) uw[ai][m][bj] = ldg<u32x4>(ib + (size_t)(ai * 128 + m * 16) * KC + bj * 128, vin);
        }
        EPI_ROWS(ai, m) {
#pragma unroll
            for (int bj = 0; bj < 2; ++bj) {
                f32x4 u0, u1; unpack8(uw[ai][m][bj], u0, u1);
                f32x4 v0 = acc[ai][bj][m][0] + d0 * u0, v1 = acc[ai][bj][m][1] + d1 * u1;
#pragma unroll
                for (int q = 0; q < 4; ++q) { v0[q] = gelu_tanh(v0[q]); v1[q] = gelu_tanh(v1[q]); }
                stg<u32x4>(ob + ((size_t)(ai * 128 + m * 16) * LC + 8 * bj) * DS, vout, pack8(v0, v1));
            }
        }
    }
};
struct EpiGlu {
    static constexpr bool MID = false;
    const bf16* yapre; const float* bias; bf16* Y; float* ssqa;
    __device__ __forceinline__ void mid(acc_t&, const Unit&, int, int, int, int) const {}
    __device__ __forceinline__ void operator()(const acc_t& acc, const Unit& u, int wr, int wc, int fr, int fq) const {
        asm volatile("" : "+v"(fr), "+v"(fq));
        const unsigned vin = (unsigned)(((wr * 64 + fr) * DS + wc * 32 + 8 * fq) * 2), vout = (unsigned)(((wr * 64 + fr) * D + wc * 32 + 8 * fq) * 2);
        const unsigned vcol = (unsigned)((wc * 32 + 8 * fq) * 4), vss = (unsigned)(((wr * 64 + fr) * 16 + wc) * 4);
        const bf16* ib = yapre + (size_t)u.pm * 256 * DS + u.pn * 256; bf16* ob = Y + (size_t)u.pm * 256 * D + u.pn * 256; float* sbp = ssqa + (size_t)u.pm * 256 * 16 + u.pn * 4;
        f32x4 bv[2][2]; u32x4 yw[2][4][2];
        EPI_ROWS(ai, m) {
#pragma unroll
            for (int bj = 0; bj < 2; ++bj) yw[ai][m][bj] = ldg<u32x4>(ib + (size_t)(ai * 128 + m * 16) * DS + bj * 128, vin);
        }
#pragma unroll
        for (int bj = 0; bj < 2; ++bj) { bv[bj][0] = ldg<f32x4>(bias + u.pn * 256 + bj * 128, vcol); bv[bj][1] = ldg<f32x4>(bias + u.pn * 256 + bj * 128 + 4, vcol); }
        EPI_ROWS(ai, m) {
            float ss = 0.f;
#pragma unroll
            for (int bj = 0; bj < 2; ++bj) {
                f32x4 y0, y1; unpack8(yw[ai][m][bj], y0, y1);
                f32x4 v0 = acc[ai][bj][m][0] + bv[bj][0], v1 = acc[ai][bj][m][1] + bv[bj][1];
#pragma unroll
                for (int q = 0; q < 4; ++q) { v0[q] = y0[q] * fast_sigmoid(v0[q]); v1[q] = y1[q] * fast_sigmoid(v1[q]); }
                ss += sumsq8(v0, v1);
                stg<u32x4>(ob + (size_t)(ai * 128 + m * 16) * D + bj * 128, vout, pack8(v0, v1));
            }
            ss += __shfl_xor(ss, 16); ss += __shfl_xor(ss, 32);
            if (fq == 0) stg<float>(sbp + (size_t)(ai * 128 + m * 16) * 16, vss, ss);
        }
    }
};
struct EpiProj {
    static constexpr bool MID = false;
    bf16* proj;
    __device__ __forceinline__ void mid(acc_t&, const Unit&, int, int, int, int) const {}
    __device__ __forceinline__ void operator()(const acc_t& acc, const Unit& u, int wr, int wc, int fr, int fq) const {
        asm volatile("" : "+v"(fr), "+v"(fq));
        EPI_ROWS(ai, m) {
            const int row = u.pm * 256 + ai * 128 + wr * 64 + m * 16 + fr;
#pragma unroll
            for (int bj = 0; bj < 2; ++bj) { const int col = u.pn * 256 + bj * 128 + wc * 32 + 8 * fq; *(u32x4*)(proj + (size_t)row * D + col) = pack8(acc[ai][bj][m][0], acc[ai][bj][m][1]); }
        }
    }
};
struct EpiOut {
    static constexpr bool MID = true;
    const float* ssqa; const float* ssqb; bf16* xb; float* ssq1;
    __device__ __forceinline__ void mid(acc_t& acc, const Unit& u, int wr, int wc, int fr, int fq) const {
        asm volatile("" : "+v"(fr), "+v"(fq));
        const unsigned va = (unsigned)(((wr * 64 + fr) * 16 + 4 * fq) * 4), vb = (unsigned)(((wr * 64 + fr) * 8 + 2 * fq) * 4);
        const float* ab = ssqa + (size_t)u.pm * 256 * 16; const float* bb = ssqb + (size_t)u.pm * 256 * 8;
        float sa[2][4], sb[2][4];
        EPI_ROWS(ai, m) { sa[ai][m] = row_part2<16>(ab + (size_t)(ai * 128 + m * 16) * 16, va); sb[ai][m] = row_part2<8>(bb + (size_t)(ai * 128 + m * 16) * 8, vb); }
        EPI_ROWS(ai, m) {
            const float ratio = sqrtf((sb[ai][m] * (1.0f / 1024.0f) + EPS) / (sa[ai][m] * (1.0f / 1024.0f) + EPS));
#pragma unroll
            for (int bj = 0; bj < 2; ++bj) { acc[ai][bj][m][0] *= ratio; acc[ai][bj][m][1] *= ratio; }
        }
    }
    __device__ __forceinline__ void operator()(const acc_t& acc, const Unit& u, int wr, int wc, int fr, int fq) const {
        asm volatile("" : "+v"(fr), "+v"(fq));
        const unsigned vx = (unsigned)(((wr * 64 + fr) * D + wc * 32 + 8 * fq) * 2), vb = (unsigned)(((wr * 64 + fr) * 8 + 2 * fq) * 4), vss = (unsigned)(((wr * 64 + fr) * 32 + wc) * 4);
        bf16* xt = xb + (size_t)u.pm * 256 * D + u.pn * 256; const float* bb = ssqb + (size_t)u.pm * 256 * 8; float* sp = ssq1 + (size_t)u.pm * 256 * 32 + u.pn * 4;
        u32x4 xw[2][4][2]; float sb[2][4];
        EPI_ROWS(ai, m) {
#pragma unroll
            for (int bj = 0; bj < 2; ++bj) xw[ai][m][bj] = ldg<u32x4>(xt + (size_t)(ai * 128 + m * 16) * D + bj * 128, vx);
            sb[ai][m] = row_part2<8>(bb + (size_t)(ai * 128 + m * 16) * 8, vb);
        }
        EPI_ROWS(ai, m) {
            const float rb = 1.0f / sqrtf(sb[ai][m] * (1.0f / 1024.0f) + EPS); float ss = 0.f;
#pragma unroll
            for (int bj = 0; bj < 2; ++bj) {
                f32x4 x0, x1; unpack8(xw[ai][m][bj], x0, x1);
                const f32x4 v0 = x0 + acc[ai][bj][m][0] * rb, v1 = x1 + acc[ai][bj][m][1] * rb;
                stg<u32x4>(xt + (size_t)(ai * 128 + m * 16) * D + bj * 128, vx, pack8(v0, v1)); ss += sumsq8(v0, v1);
            }
            ss += __shfl_xor(ss, 16); ss += __shfl_xor(ss, 32);
            if (fq == 0) stg<float>(sp + (size_t)(ai * 128 + m * 16) * 32, vss, ss);
        }
    }
};
struct EpiFfnIn {
    static constexpr bool MID = false;
    const float* ssq1; bf16* h;
    __device__ __forceinline__ void mid(acc_t&, const Unit&, int, int, int, int) const {}
    __device__ __forceinline__ void operator()(const acc_t& acc, const Unit& u, int wr, int wc, int fr, int fq) const {
        asm volatile("" : "+v"(fr), "+v"(fq));
        const unsigned vs = (unsigned)(((wr * 64 + fr) * 32 + 8 * fq) * 4), vh = (unsigned)(((wr * 64 + fr) * FF + wc * 32 + 8 * fq) * 2);
        const float* sp = ssq1 + (size_t)u.pm * 256 * 32; bf16* hb = h + (size_t)u.pm * 256 * FF + u.pn * 128;
        float s1[2][4];
        EPI_ROWS(ai, m) s1[ai][m] = row_part2<32>(sp + (size_t)(ai * 128 + m * 16) * 32, vs);
        EPI_ROWS(ai, m) {
            const float r1 = 1.0f / sqrtf(s1[ai][m] * (1.0f / 2048.0f) + EPS);
            f32x4 g0 = acc[ai][0][m][0] * r1, g1 = acc[ai][0][m][1] * r1; const f32x4 u0 = acc[ai][1][m][0] * r1, u1 = acc[ai][1][m][1] * r1;
#pragma unroll
            for (int q = 0; q < 4; ++q) { g0[q] = silu(g0[q]) * u0[q]; g1[q] = silu(g1[q]) * u1[q]; }
            stg<u32x4>(hb + (size_t)(ai * 128 + m * 16) * FF, vh, pack8(g0, g1));
        }
    }
};
struct EpiFfnOut {
    static constexpr bool MID = false;
    bf16* xb; float* ssq2;
    __device__ __forceinline__ void mid(acc_t&, const Unit&, int, int, int, int) const {}
    __device__ __forceinline__ void operator()(const acc_t& acc, const Unit& u, int wr, int wc, int fr, int fq) const {
        asm volatile("" : "+v"(fr), "+v"(fq));
        const unsigned vx = (unsigned)(((wr * 64 + fr) * D + wc * 32 + 8 * fq) * 2), vss = (unsigned)(((wr * 64 + fr) * 32 + wc) * 4);
        bf16* xt = xb + (size_t)u.pm * 256 * D + u.pn * 256; float* sp = ssq2 + (size_t)u.pm * 256 * 32 + u.pn * 4;
        u32x4 xw[2][4][2];
        EPI_ROWS(ai, m) {
#pragma unroll
            for (int bj = 0; bj < 2; ++bj) xw[ai][m][bj] = ldg<u32x4>(xt + (size_t)(ai * 128 + m * 16) * D + bj * 128, vx);
        }
        EPI_ROWS(ai, m) {
            float ss = 0.f;
#pragma unroll
            for (int bj = 0; bj < 2; ++bj) {
                f32x4 x0, x1; unpack8(xw[ai][m][bj], x0, x1);
                const f32x4 v0 = x0 + acc[ai][bj][m][0], v1 = x1 + acc[ai][bj][m][1];
                stg<u32x4>(xt + (size_t)(ai * 128 + m * 16) * D + bj * 128, vx, pack8(v0, v1)); ss += sumsq8(v0, v1);
            }
            ss += __shfl_xor(ss, 16); ss += __shfl_xor(ss, 32);
            if (fq == 0) stg<float>(sp + (size_t)(ai * 128 + m * 16) * 32, vss, ss);
        }
    }
};
struct EpiPle {
    static constexpr bool MID = false;
    const float* ssq2; const float* bias; const bf16* proj; const bf16* xb; float* xo; float* ssq3;
    __device__ __forceinline__ void mid(acc_t&, const Unit&, int, int, int, int) const {}
    __device__ __forceinline__ void operator()(const acc_t& acc, const Unit& u, int wr, int wc, int fr, int fq) const {
        asm volatile("" : "+v"(fr), "+v"(fq));
        const unsigned vx = (unsigned)(((wr * 64 + fr) * D + wc * 32 + 8 * fq) * 2), vo = 2 * vx, vs = (unsigned)(((wr * 64 + fr) * 32 + 8 * fq) * 4), vss = (unsigned)(((wr * 64 + fr) * 32 + wc) * 4);
        const unsigned vcol = (unsigned)((wc * 32 + 8 * fq) * 4);
        const size_t toff = (size_t)u.pm * 256 * D + u.pn * 256;
        const bf16* xt = xb + toff; const bf16* pt = proj + toff; float* ot = xo + toff; const float* s2p = ssq2 + (size_t)u.pm * 256 * 32; float* sp = ssq3 + (size_t)u.pm * 256 * 32 + u.pn * 4;
        f32x4 bv[2][2];
#pragma unroll
        for (int bj = 0; bj < 2; ++bj) { bv[bj][0] = ldg<f32x4>(bias + u.pn * 256 + bj * 128, vcol); bv[bj][1] = ldg<f32x4>(bias + u.pn * 256 + bj * 128 + 4, vcol); }
        float s2a[2][4];
        EPI_ROWS(ai, m) s2a[ai][m] = row_part2<32>(s2p + (size_t)(ai * 128 + m * 16) * 32, vs);
        asm volatile("" ::: "memory");
#pragma unroll
        for (int ai = 0; ai < 2; ++ai)
#pragma unroll
        for (int mp = 0; mp < 2; ++mp) {
            u32x4 xw[2][2], pw[2][2];
#pragma unroll
            for (int mm = 0; mm < 2; ++mm) { const int m = 2 * mp + mm;
#pragma unroll
                for (int bj = 0; bj < 2; ++bj) { xw[mm][bj] = ldg<u32x4>(xt + (size_t)(ai * 128 + m * 16) * D + bj * 128, vx); pw[mm][bj] = ldg<u32x4>(pt + (size_t)(ai * 128 + m * 16) * D + bj * 128, vx); }
            }
#pragma unroll
            for (int mm = 0; mm < 2; ++mm) { const int m = 2 * mp + mm;
                const float r2 = 1.0f / sqrtf(s2a[ai][m] * (1.0f / 2048.0f) + EPS); float ss = 0.f;
#pragma unroll
                for (int bj = 0; bj < 2; ++bj) {
                    f32x4 p0, p1, x0, x1; unpack8(pw[mm][bj], p0, p1); unpack8(xw[mm][bj], x0, x1);
                    f32x4 v0 = acc[ai][bj][m][0] * r2 + bv[bj][0], v1 = acc[ai][bj][m][1] * r2 + bv[bj][1];
#pragma unroll
                    for (int q = 0; q < 4; ++q) { v0[q] = x0[q] + fast_sigmoid(v0[q]) * p0[q]; v1[q] = x1[q] + fast_sigmoid(v1[q]) * p1[q]; }
                    float* op = ot + (size_t)(ai * 128 + m * 16) * D + bj * 128;
                    stg<f32x4>(op, vo, v0); stg<f32x4>(op + 4, vo, v1); ss += sumsq8(v0, v1);
                }
                ss += __shfl_xor(ss, 16); ss += __shfl_xor(ss, 32);
                if (fq == 0) stg<float>(sp + (size_t)(ai * 128 + m * 16) * 32, vss, ss);
            }
            asm volatile("" ::: "memory");
        }
    }
};

#define XB_TMO      128
#define XB_XCNT(j)  (256  + 64 * (j))
#define XB_XSUB(j)  (1280 + 64 * (j))
#define XB_XGEN(j)  (2304 + 64 * (j))
#define XB_TOP      3328
#define XB_TOPGEN   3392
#define XCD_BAR_WORDS 3456
#define XB_SPIN_CAP (1u << 18)
__device__ __forceinline__ unsigned xb_ld(unsigned* p)              { return __hip_atomic_load(p, __ATOMIC_RELAXED, __HIP_MEMORY_SCOPE_AGENT); }
__device__ __forceinline__ unsigned xb_add(unsigned* p, unsigned v) { return __hip_atomic_fetch_add(p, v, __ATOMIC_RELAXED, __HIP_MEMORY_SCOPE_AGENT); }
__device__ __forceinline__ unsigned xb_xcc_id() { return (unsigned)__builtin_amdgcn_s_getreg((3 << 11) | 20) & 0xFu; }
#define XB_SPIN(cond, bar) do { unsigned _sp = 0; while (cond) { __builtin_amdgcn_s_sleep(1); \
    if ((++_sp & 255u) == 0u) { if (xb_ld(&(bar)[XB_TMO])) break; if (_sp > XB_SPIN_CAP) { atomicAdd(&(bar)[XB_TMO], 1u); break; } } } } while (0)
struct XcdBarrier { unsigned* bar; unsigned x; volatile LAS unsigned* st; };
__device__ __forceinline__ XcdBarrier xcd_barrier_post(unsigned* bar, volatile LAS unsigned* st) {
    XcdBarrier b; b.bar = bar; b.x = xb_xcc_id(); b.st = st;
    if (threadIdx.x == 0) (void)xb_add(&bar[XB_XCNT(b.x)], 1u);
    return b;
}
__device__ __forceinline__ void xcd_barrier_complete(unsigned* bar, unsigned x, unsigned& nloc, unsigned& nx) {
    const unsigned G = gridDim.x * gridDim.y * gridDim.z;
    unsigned sum, cnt, mine, sp = 0u;
    for (;;) {
        sum = 0u; cnt = 0u; mine = 0u;
#pragma unroll
        for (unsigned j = 0; j < 16; ++j) { const unsigned c = xb_ld(&bar[XB_XCNT(j)]); sum += c; cnt += (c > 0u) ? 1u : 0u; mine = (j == x) ? c : mine; }
        if (sum == G) break;
        __builtin_amdgcn_s_sleep(1);
        if ((++sp & 255u) == 0u) { if (xb_ld(&bar[XB_TMO])) break; if (sp > XB_SPIN_CAP) { atomicAdd(&bar[XB_TMO], 1u); break; } }
    }
    nloc = mine > 0u ? mine : 1u; nx = cnt > 0u ? cnt : 1u;
}
__device__ __forceinline__ void xcd_barrier(const XcdBarrier& b) {
    asm volatile("s_waitcnt vmcnt(0)" ::: "memory");
    __syncthreads();
    if (threadIdx.x == 0) {
        unsigned* bar = b.bar;
        __builtin_amdgcn_s_waitcnt(0);
        unsigned nloc = b.st[0], nx = b.st[1];
        if (nloc == 0u) { xcd_barrier_complete(bar, b.x, nloc, nx); b.st[0] = nloc; b.st[1] = nx; }
        const unsigned old = xb_add(&bar[XB_XSUB(b.x)], 1u);
        const unsigned gen = old / nloc;
        if (old + 1u == (gen + 1u) * nloc) {
            __builtin_amdgcn_fence(__ATOMIC_RELEASE, "agent");
            asm volatile("s_waitcnt vmcnt(0)" ::: "memory");
            const unsigned og = xb_add(&bar[XB_TOP], 1u);
            const unsigned tg = og / nx;
            if (og + 1u == (tg + 1u) * nx) xb_add(&bar[XB_TOPGEN], 1u);
            else XB_SPIN(xb_ld(&bar[XB_TOPGEN]) == tg, bar);
            __builtin_amdgcn_fence(__ATOMIC_ACQUIRE, "agent");
            xb_add(&bar[XB_XGEN(b.x)], 1u);
            asm volatile("s_waitcnt vmcnt(0)" ::: "memory");
        } else {
            XB_SPIN(xb_ld(&bar[XB_XGEN(b.x)]) == gen, bar);
            __builtin_amdgcn_fence(__ATOMIC_ACQUIRE, "agent");
            asm volatile("s_waitcnt vmcnt(0)" ::: "memory");
        }
    }
    __syncthreads();
}

struct Args { const float* in[29]; float* out; unsigned char* ws; int ph_lo, ph_hi, li, pad; };
enum In { I_X = 0, I_P, I_NMIXG, I_WIN, I_LRE, I_LIM, I_LSTEP, I_BRE, I_BIM, I_CRE, I_CIM, I_SD, I_GLUW, I_GLUB, I_LNG, I_LNB, I_SGUW, I_SGUB,
          I_ONSSM, I_ONSGU, I_WOUT, I_NFFNG, I_WFFI, I_WFFO, I_NPLEG, I_WG, I_BG, I_WPLE, I_FNG };

__device__ __forceinline__ const float* kin(int i) {
    int off = i * 8; asm volatile("" : "+s"(off));
    return *(const float* const*)((const char*)__builtin_amdgcn_kernarg_segment_ptr() + off);
}
__device__ __forceinline__ void p0_transpose_item(const float* W, int N, const float* gain, bf16* WT, int ldt, int dst_row0, int k0, int n0, LAS float* scr, int lane) {
    float v[32];
    const float* src = W + (size_t)(k0 + (lane >> 5)) * N + n0 + (lane & 31);
#pragma unroll
    for (int i = 0; i < 32; ++i) v[i] = src[(size_t)(2 * i) * N];
    if (gain) {
#pragma unroll
        for (int i = 0; i < 32; ++i) v[i] *= gain[k0 + 2 * i + (lane >> 5)];
    }
#pragma unroll
    for (int i = 0; i < 32; ++i) scr[(2 * i + (lane >> 5)) * 33 + (lane & 31)] = v[i];
    LDS_WAIT(); asm volatile("" ::: "memory");
    const int c = lane & 7;
#pragma unroll
    for (int j = 0; j < 4; ++j) { const int n = (lane >> 3) + 8 * j; const LAS float* s = scr + (8 * c) * 33 + n;
        u32x4 o; o.x = cvt_pk_bf16(s[0 * 33], s[1 * 33]); o.y = cvt_pk_bf16(s[2 * 33], s[3 * 33]); o.z = cvt_pk_bf16(s[4 * 33], s[5 * 33]); o.w = cvt_pk_bf16(s[6 * 33], s[7 * 33]);
        *(u32x4*)(WT + (size_t)(dst_row0 + n) * ldt + k0 + 8 * c) = o; }
    LDS_WAIT(); asm volatile("" ::: "memory");
}
template <int MODE>
__device__ __forceinline__ void p0_transpose(const float* W, int K, int N, const float* gain, const float* gain2, bf16* WT, LAS float* scr, int gw, int ngw, int lane) {
    const int nblk = N / 32, nitems = (K / 64) * nblk;
    for (int it = gw; it < nitems; it += ngw) {
        const int kb = it / nblk, nb = it % nblk, k0 = 64 * kb, n0 = 32 * nb;
        int dst = n0;
        if (MODE == 1) { const int half = (n0 >= FF) ? 1 : 0, j = n0 - half * FF; dst = 256 * (j >> 7) + 128 * half + (j & 127); }
        const float* g = gain; if (gain2 && k0 >= 1024) g = gain2 - 1024;
        p0_transpose_item(W, N, g, WT, K, dst, k0, n0, scr, lane);
    }
}
__device__ __forceinline__ void p0_s5_tables(const Args& a, int g, LAS float* L, int tid) {
    LAS float* apow = L;
    LAS float* Bb = L + 2176;
    LAS float* Cc = L + 2176 + 2048;
    LAS float* Kk = L + 2176 + 4096;
    bf16* TF = (bf16*)(a.ws + WS_TF) + (size_t)g * 256 * KC;
    bf16* E = (bf16*)(a.ws + WS_E) + (size_t)g * 128 * KA;
    float* A16 = (float*)(a.ws + WS_A16) + (size_t)g * NP * 2;
    if (tid < NP) {
        const int p = tid;
        const double lr = fmin((double)kin(I_LRE)[g * NP + p], -1e-4), li = (double)kin(I_LIM)[g * NP + p];
        const double dt = exp((double)kin(I_LSTEP)[g]);
        const double mg = exp(lr * dt); double sn, cs; sincos(li * dt, &sn, &cs);
        { const double a1r = mg * cs, a1i = mg * sn; double pr = 1.0, pi = 0.0;
          for (int k = 0; k <= LC; ++k) { apow[(k * NP + p) * 2] = (float)pr; apow[(k * NP + p) * 2 + 1] = (float)pi; const double nr = pr * a1r - pi * a1i, ni = pr * a1i + pi * a1r; pr = nr; pi = ni; } }
        const double nr = mg * cs - 1.0, ni = mg * sn, den = lr * lr + li * li;
        const double qre = (nr * lr + ni * li) / den, qim = (ni * lr - nr * li) / den;
        for (int h = 0; h < NH; ++h) { const double br = (double)kin(I_BRE)[(g * NP + p) * NH + h], bi = (double)kin(I_BIM)[(g * NP + p) * NH + h];
            Bb[(p * NH + h) * 2] = (float)(qre * br - qim * bi); Bb[(p * NH + h) * 2 + 1] = (float)(qre * bi + qim * br); }
        A16[p * 2] = apow[(LC * NP + p) * 2]; A16[p * 2 + 1] = apow[(LC * NP + p) * 2 + 1];
    }
    for (int e = tid; e < NH * NP; e += 512) { Cc[e * 2] = kin(I_CRE)[g * NH * NP + e]; Cc[e * 2 + 1] = kin(I_CIM)[g * NH * NP + e]; }
    __syncthreads();
    {
        const int kh = tid >> 1, k = kh >> 4, ho = kh & 15, hi0 = 8 * (tid & 1); float s8[8];
#pragma unroll
        for (int q = 0; q < 8; ++q) s8[q] = 0.f;
#pragma unroll 4
        for (int p = 0; p < NP; ++p) {
            const f32x2 c = *(const LAS f32x2*)(Cc + (ho * NP + p) * 2), av = *(const LAS f32x2*)(apow + (k * NP + p) * 2);
            const float zr = c[0] * av[0] - c[1] * av[1], zi = c[0] * av[1] + c[1] * av[0];
#pragma unroll
            for (int q = 0; q < 8; q += 2) { const f32x4 b = *(const LAS f32x4*)(Bb + (p * NH + hi0 + q) * 2); s8[q] += zr * b[0] - zi * b[1]; s8[q + 1] += zr * b[2] - zi * b[3]; }
        }
#pragma unroll
        for (int q = 0; q < 8; ++q) Kk[kh * 16 + hi0 + q] = s8[q];
    }
    __syncthreads();
    for (int e = tid; e < 256 * 128; e += 512) {
        const int row = e >> 7, kc = (e & 127) * 2, j = row >> 4, ho = row & 15, i = kc >> 4, hi = kc & 15;
        f32x2 v = (f32x2){0.f, 0.f}; if (i <= j) v = *(const LAS f32x2*)(Kk + ((j - i) * 16 + ho) * 16 + hi);
        *(unsigned*)(TF + (size_t)row * KC + kc) = cvt_pk_bf16(v[0], v[1]);
    }
    for (int e = tid; e < 256 * 64; e += 512) {
        const int row = e >> 6, pr = e & 63, j = row >> 4, ho = row & 15, ri = pr >> 5, p = (2 * pr) & 63;
        const f32x4 c = *(const LAS f32x4*)(Cc + (ho * NP + p) * 2), av = *(const LAS f32x4*)(apow + ((j + 1) * NP + p) * 2);
        const float v0 = ri == 0 ? (c[0] * av[0] - c[1] * av[1]) : -(c[0] * av[1] + c[1] * av[0]), v1 = ri == 0 ? (c[2] * av[2] - c[3] * av[3]) : -(c[2] * av[3] + c[3] * av[2]);
        *(unsigned*)(TF + (size_t)row * KC + 256 + 2 * pr) = cvt_pk_bf16(v0, v1);
    }
    for (int e = tid; e < 128 * 128; e += 512) {
        const int row = e >> 7, kc = (e & 127) * 2, ri = row >> 6, p = row & 63, i = kc >> 4, hi = kc & 15;
        const f32x2 av = *(const LAS f32x2*)(apow + ((LC - 1 - i) * NP + p) * 2); const f32x4 b = *(const LAS f32x4*)(Bb + (p * NH + hi) * 2);
        const float v0 = ri == 0 ? (av[0] * b[0] - av[1] * b[1]) : (av[0] * b[1] + av[1] * b[0]), v1 = ri == 0 ? (av[0] * b[2] - av[1] * b[3]) : (av[0] * b[3] + av[1] * b[2]);
        *(unsigned*)(E + (size_t)row * KA + kc) = cvt_pk_bf16(v0, v1);
    }
    __syncthreads();
}

__device__ __forceinline__ void s5_scan(const Args& a, int g, int b, LAS unsigned char* lds, int wave, int lane) {
    asm volatile("" : "+v"(lane));
    const float* sloc = (const float*)(a.ws + WS_SLOC) + (size_t)(g * NCH + b * 256 + wave * 32) * 128;
    bf16* AC = (bf16*)(a.ws + WS_AC) + (size_t)(g * NCH + b * 256 + wave * 32) * KC + 256;
    const float* A16 = (const float*)(a.ws + WS_A16) + (size_t)g * NP * 2;
    const float ar = A16[lane * 2], ai = A16[lane * 2 + 1];
    float xr[32], xi[32];
#pragma unroll
    for (int j = 0; j < 32; ++j) { xr[j] = sloc[j * 128 + lane]; xi[j] = sloc[j * 128 + 64 + lane]; }
    float sr = 0.f, si = 0.f;
#pragma unroll
    for (int j = 0; j < 32; ++j) { const float nr = ar * sr - ai * si + xr[j], ni = ar * si + ai * sr + xi[j]; sr = nr; si = ni; }
    LAS float* ex = (LAS float*)lds;
    ex[(wave * 64 + lane) * 2] = sr; ex[(wave * 64 + lane) * 2 + 1] = si;
    float pr = ar, pi = ai;
#pragma unroll
    for (int q = 0; q < 5; ++q) { const float nr = pr * pr - pi * pi, ni = 2.f * pr * pi; pr = nr; pi = ni; }
    __syncthreads();
    float cr = 0.f, ci = 0.f;
    for (int v = 0; v < wave; ++v) { const float er = ex[(v * 64 + lane) * 2], ei = ex[(v * 64 + lane) * 2 + 1]; const float nr = pr * cr - pi * ci + er, ni = pr * ci + pi * cr + ei; cr = nr; ci = ni; }
    sr = cr; si = ci;
#pragma unroll
    for (int j = 0; j < 32; ++j) {
        AC[(size_t)j * KC + lane] = (bf16)(cvt_pk_bf16(sr, 0.f) & 0xffffu); AC[(size_t)j * KC + 64 + lane] = (bf16)(cvt_pk_bf16(si, 0.f) & 0xffffu);
        const float nr = ar * sr - ai * si + xr[j], ni = ar * si + ai * sr + xi[j]; sr = nr; si = ni;
    }
    VM_WAIT(); __syncthreads();
}

constexpr int SGU_LDV = 136;
__device__ __forceinline__ void sgu_unit(const Args& a, int n, int h, LAS unsigned char* lds, int tid, int wave, int lane) {
    asm volatile("" : "+v"(tid), "+v"(lane));
    LAS bf16* Vt = (LAS bf16*)lds;
    LAS float* st = (LAS float*)(lds + 36864);
    const int tok0 = n * 128, fr = lane & 15, fq = lane >> 4;
    const bf16* gv = (const bf16*)(a.ws + WS_GV); const bf16* gu = (const bf16*)(a.ws + WS_GU); bf16* Y = (bf16*)(a.ws + WS_Y);
    if (tid < 128) {
        const float* ls = (const float*)(a.ws + WS_LNST) + (size_t)(tok0 + tid) * 32; float s1 = 0.f, s2 = 0.f;
#pragma unroll
        for (int q = 0; q < 8; ++q) { const f32x4 v = *(const f32x4*)(ls + 4 * q); s1 += v[0] + v[2]; s2 += v[1] + v[3]; }
        const float mu = s1 * (1.0f / 1024.0f), var = s2 * (1.0f / 1024.0f) - mu * mu;
        st[tid * 2] = mu; st[tid * 2 + 1] = 1.0f / sqrtf(var + EPS);
    }
    __syncthreads();
#pragma unroll
    for (int i = 0; i < 4; ++i) {
        const int q = tid + 512 * i, s = q & 127, c8 = q >> 7;
        const u32x4 w = *(const u32x4*)(gv + (size_t)(tok0 + s) * DG + h * 128 + 8 * c8);
        f32x4 v0, v1; unpack8(w, v0, v1);
        const f32x4 g0 = *(const f32x4*)(kin(I_LNG) + h * 128 + 8 * c8), g1 = *(const f32x4*)(kin(I_LNG) + h * 128 + 8 * c8 + 4);
        const f32x4 b0 = *(const f32x4*)(kin(I_LNB) + h * 128 + 8 * c8), b1 = *(const f32x4*)(kin(I_LNB) + h * 128 + 8 * c8 + 4);
        const float mu = st[s * 2], rstd = st[s * 2 + 1];
        v0 = (v0 - mu) * rstd * g0 + b0; v1 = (v1 - mu) * rstd * g1 + b1;
        const unsigned p0 = cvt_pk_bf16(v0[0], v0[1]), p1 = cvt_pk_bf16(v0[2], v0[3]), p2 = cvt_pk_bf16(v1[0], v1[1]), p3 = cvt_pk_bf16(v1[2], v1[3]);
        LAS bf16* d = Vt + (8 * c8) * SGU_LDV + s;
        d[0 * SGU_LDV] = (bf16)(p0 & 0xffffu); d[1 * SGU_LDV] = (bf16)(p0 >> 16); d[2 * SGU_LDV] = (bf16)(p1 & 0xffffu); d[3 * SGU_LDV] = (bf16)(p1 >> 16);
        d[4 * SGU_LDV] = (bf16)(p2 & 0xffffu); d[5 * SGU_LDV] = (bf16)(p2 >> 16); d[6 * SGU_LDV] = (bf16)(p3 & 0xffffu); d[7 * SGU_LDV] = (bf16)(p3 >> 16);
    }
    __syncthreads();
    f32x4 acc[8];
#pragma unroll
    for (int j = 0; j < 8; ++j) acc[j] = (f32x4){0.f, 0.f, 0.f, 0.f};
    const int t = 16 * wave + fr;
    const float* wrow = kin(I_SGUW) + ((size_t)h * 128 + t) * 128;
#pragma unroll
    for (int kk = 0; kk < 4; ++kk) {
        if (32 * kk <= 16 * wave + 15) {
            const int s0 = 32 * kk + 8 * fq;
            f32x4 w0 = *(const f32x4*)(wrow + s0), w1 = *(const f32x4*)(wrow + s0 + 4);
#pragma unroll
            for (int q = 0; q < 4; ++q) { if (s0 + q > t) w0[q] = 0.f; if (s0 + 4 + q > t) w1[q] = 0.f; }
            const u32x4 aw = pack8(w0, w1); bf16x8 af; __builtin_memcpy(&af, &aw, 16);
#pragma unroll
            for (int j = 0; j < 8; ++j) {
                const bf16x8 bfr = *(const LAS bf16x8*)(Vt + (16 * j + fr) * SGU_LDV + 32 * kk + 8 * fq);
                acc[j] = __builtin_amdgcn_mfma_f32_16x16x32_bf16(bfr, af, acc[j], 0, 0, 0);
            }
        }
    }
    const float bias = kin(I_SGUB)[h * 128 + t]; float ss = 0.f;
    const size_t tok = (size_t)(tok0 + t);
#pragma unroll
    for (int j = 0; j < 8; ++j) {
        const int c = h * 128 + 16 * j + 4 * fq;
        const u32x2 gw = *(const u32x2*)(gu + tok * DG + c);
        f32x4 o; o[0] = (acc[j][0] + bias) * bf_lo(gw.x); o[1] = (acc[j][1] + bias) * bf_hi(gw.x); o[2] = (acc[j][2] + bias) * bf_lo(gw.y); o[3] = (acc[j][3] + bias) * bf_hi(gw.y);
        ss += (o[0] * o[0] + o[1] * o[1]) + (o[2] * o[2] + o[3] * o[3]);
        u32x2 ow; ow.x = cvt_pk_bf16(o[0], o[1]); ow.y = cvt_pk_bf16(o[2], o[3]);
        *(u32x2*)(Y + tok * D + 1024 + c) = ow;
    }
    ss += __shfl_xor(ss, 16); ss += __shfl_xor(ss, 32);
    if (fq == 0) ((float*)(a.ws + WS_SSQB))[tok * 8 + h] = ss;
    __syncthreads();
}

constexpr int PER_PHASE = 10;
__global__ void __launch_bounds__(NWAVES * 64, 2) hybrid_fwd(Args args) {
    extern __shared__ __attribute__((aligned(16))) unsigned char lds_raw[];
    LAS unsigned char* lds = (LAS unsigned char*)lds_raw;
    volatile LAS unsigned* MISC = (volatile LAS unsigned*)(lds + MISC_OFF);
    const int tid = threadIdx.x, lane = tid & 63, wave = __builtin_amdgcn_readfirstlane(tid >> 6);
    const int G = gridDim.x, bx = blockIdx.x;
    const int vcu = (G % 8 == 0) ? (bx % 8) * (G / 8) + bx / 8 : bx;
    unsigned char* ws = args.ws;
    for (int u = tid; u < (LDS_BYTES - LDSCTL_OFF) / 4; u += NWAVES * 64) ((LAS unsigned*)(lds + LDSCTL_OFF))[u] = 0u;
    __syncthreads();
    XcdBarrier bar; bar.bar = (unsigned*)(ws + WS_CTL) + CW_BAR + args.li * XCD_BAR_WORDS; bar.x = 0; bar.st = nullptr;
    if (MK_N_LAUNCHES != PER_PHASE) bar = xcd_barrier_post((unsigned*)(ws + WS_CTL) + CW_BAR + args.li * XCD_BAR_WORDS, MISC + 8);
    const int lo = args.ph_lo, hi = args.ph_hi;
#ifndef PHASE_MASK
#define PHASE_MASK 0x3ff
#endif
#define IN(k) (((PHASE_MASK >> (k)) & 1) && lo <= (k) && (k) < hi)
#ifndef PROBE_PHASE
#define PROBE_PHASE (-1)
#endif
#define STAMP(k) do { if (PROBE_PHASE >= 0 && bx == 0 && tid == 0) MISC[12 + (k)] = (unsigned)__builtin_amdgcn_s_memrealtime(); } while (0)
#define STAMPX(i) do { if (PROBE_PHASE >= 100 && bx == 0 && tid == 0) MISC[24 + (i)] = (unsigned)__builtin_amdgcn_s_memrealtime(); } while (0)
#define SEAM(k) do { if (IN(k) && IN((k) + 1)) xcd_barrier(bar); STAMP((k) + 1); } while (0)
    STAMP(0);
    const int gw = vcu * NWAVES + wave, ngw = G * NWAVES;
    const bool split = (G == 256);
    const int roleA = split ? (((bx >> 3) & 1) == 0) : 1, roleB = split ? !roleA : 1;
    const int ridx = split ? (((bx >> 4) << 3) | (bx & 7)) : bx, RG = split ? 128 : G;

    bf16* WT_in = (bf16*)(ws + WS_WIN); bf16* WT_glu = (bf16*)(ws + WS_WGLU); bf16* WT_out = (bf16*)(ws + WS_WOUT); bf16* WT_ffi = (bf16*)(ws + WS_WFFI);
    bf16* WT_ffo = (bf16*)(ws + WS_WFFO); bf16* WT_g = (bf16*)(ws + WS_WG); bf16* WT_ple = (bf16*)(ws + WS_WPLE);
    bf16* XB = (bf16*)(ws + WS_XB); bf16* PB = (bf16*)(ws + WS_PB); bf16* AC = (bf16*)(ws + WS_AC);

    if (IN(0)) {
        LAS float* scr = (LAS float*)(lds + wave * 16384);
        if (bx < NG) p0_s5_tables(args, bx, (LAS float*)lds, tid);
        p0_transpose<0>(kin(I_WIN), D, NIN, kin(I_NMIXG), nullptr, WT_in, scr, gw, ngw, lane);
        p0_transpose<0>(kin(I_WPLE), PLE, D, nullptr, nullptr, WT_ple, scr, gw, ngw, lane);
        float* r0 = (float*)(ws + WS_R0);
        for (int m = gw; m < T; m += ngw) {
            const f32x4* xr = (const f32x4*)(kin(I_X) + (size_t)m * D) + lane; u32x2* o = (u32x2*)(XB + (size_t)m * D) + lane; float ss = 0.f;
#pragma unroll
            for (int j = 0; j < 8; ++j) { const f32x4 v = xr[64 * j]; ss += (v[0] * v[0] + v[1] * v[1]) + (v[2] * v[2] + v[3] * v[3]); u32x2 w; w.x = cvt_pk_bf16(v[0], v[1]); w.y = cvt_pk_bf16(v[2], v[3]); o[64 * j] = w; }
            ss = wave_sum(ss);
            if (lane == 0) r0[m] = 1.0f / sqrtf(ss * (1.0f / 2048.0f) + EPS);
        }
        for (int e = gw * 64 + lane; e < T * PLE / 8; e += ngw * 64) { const f32x4 v0 = *((const f32x4*)kin(I_P) + 2 * e), v1 = *((const f32x4*)kin(I_P) + 2 * e + 1); *((u32x4*)PB + e) = pack8(v0, v1); }
    }
    SEAM(0);
    if (IN(1)) {
        pg8::SchedTiles S; S.init(XB, WT_in + (size_t)DS * D, T, 2 * DG, D, D, G, bx, 4);
        EpiIn E{(const float*)(ws + WS_R0), AC, (bf16*)(ws + WS_GU), (bf16*)(ws + WS_GV), (float*)(ws + WS_LNST)};
        pg8::gemm_phase<EpiIn, pg8::SchedTiles, true>(lds, D, D, D, S, E, tid);
    }
    SEAM(1);
    if (IN(2)) {
        if (roleA) {
            pg8::SchedTiles S; S.init(XB, WT_in, T, DS, D, D, RG, ridx, 0);
            EpiIn E{(const float*)(ws + WS_R0), AC, (bf16*)(ws + WS_GU), (bf16*)(ws + WS_GV), (float*)(ws + WS_LNST)};
            pg8::gemm_phase<EpiIn, pg8::SchedTiles, true>(lds, D, D, D, S, E, tid);
        }
        if (roleB) {
            for (int un = ridx; un < 512; un += RG) sgu_unit(args, un >> 3, un & 7, lds, tid, wave, lane);
        }
    }
    SEAM(2);
    if (IN(3)) {
        if (roleA) {
            for (int un = ridx; un < 2 * NG; un += RG) {
                const int g = un >> 1, b = un & 1;
                pg8::SchedOne S; S.u.A = (const char*)(AC + (size_t)(g * NCH + b * 256) * KC); S.u.pm = b; S.u.pn = 0; S.u.g = g;
                S.u.B = (const char*)((const bf16*)(ws + WS_E) + (size_t)g * 128 * KA);
                EpiSloc E1{(float*)(ws + WS_SLOC)};
                int kA = KA, kC = KC; asm volatile("" : "+s"(kA), "+s"(kC));
                pg8::gemm_phase<EpiSloc, pg8::SchedOne, false>(lds, kA, KC, KA, S, E1, tid);
                VM_WAIT(); __syncthreads();
                s5_scan(args, g, b, lds, wave, lane);
                S.u.B = (const char*)((const bf16*)(ws + WS_TF) + (size_t)g * 256 * KC);
                EpiS5Out E2{AC, kin(I_SD), (bf16*)(ws + WS_YAPRE)};
                pg8::gemm_phase<EpiS5Out, pg8::SchedOne, false>(lds, kC, KC, KC, S, E2, tid);
                __syncthreads();
            }
        }
        if (roleB) {
            pg8::SchedTiles S; S.init(PB, WT_ple, T, D, PLE, PLE, RG, ridx);
            EpiProj E{(bf16*)(ws + WS_PROJ)};
            int kP = PLE; asm volatile("" : "+s"(kP));
            pg8::gemm_phase<EpiProj, pg8::SchedTiles, true>(lds, kP, PLE, PLE, S, E, tid);
            LAS float* scr = (LAS float*)(lds + wave * 16384);
            p0_transpose<0>(kin(I_GLUW), DS, DS, nullptr, nullptr, WT_glu, scr, ridx * NWAVES + wave, RG * NWAVES, lane);
            p0_transpose<0>(kin(I_WOUT), D, D, kin(I_ONSSM), kin(I_ONSGU), WT_out, scr, ridx * NWAVES + wave, RG * NWAVES, lane);
        }
    }
    SEAM(3);
    if (IN(4)) {
        if (roleA) {
            pg8::SchedTiles S; S.init((const bf16*)(ws + WS_YAPRE), WT_glu, T, DS, DS, DS, RG, ridx);
            EpiGlu E{(const bf16*)(ws + WS_YAPRE), kin(I_GLUB), (bf16*)(ws + WS_Y), (float*)(ws + WS_SSQA)};
            pg8::gemm_phase<EpiGlu, pg8::SchedTiles, true>(lds, DS, DS, DS, S, E, tid);
        }
        if (roleB) p0_transpose<1>(kin(I_WFFI), D, 2 * FF, kin(I_NFFNG), nullptr, WT_ffi, (LAS float*)(lds + wave * 16384), ridx * NWAVES + wave, RG * NWAVES, lane);
    }
    SEAM(4);
    if (IN(5)) {
        pg8::SchedTiles S; S.init((const bf16*)(ws + WS_Y), WT_out, T, D, D, D, G, bx);
        EpiOut E{(const float*)(ws + WS_SSQA), (const float*)(ws + WS_SSQB), XB, (float*)(ws + WS_SSQ1)};
        pg8::gemm_phase<EpiOut, pg8::SchedTiles, true>(lds, D, D, D, S, E, tid);
    }
    SEAM(5);
    if (IN(6)) {
        pg8::SchedTiles S; S.init(XB, WT_ffi, T, 2 * FF, D, D, G, bx);
        EpiFfnIn E{(const float*)(ws + WS_SSQ1), (bf16*)(ws + WS_H)};
        pg8::gemm_phase<EpiFfnIn, pg8::SchedTiles, true>(lds, D, D, D, S, E, tid);
        { const int ntile = (T / 256) * (2 * FF / 256), nfull = ntile % G; LAS float* scr = (LAS float*)(lds + wave * 16384);
          const int cgw = (nfull == 0) ? gw : (bx - nfull) * NWAVES + wave, cngw = (nfull == 0) ? ngw : (G - nfull) * NWAVES;
          if (nfull == 0 || bx >= nfull) {
              p0_transpose<0>(kin(I_WFFO), FF, D, nullptr, nullptr, WT_ffo, scr, cgw, cngw, lane);
              p0_transpose<0>(kin(I_WG), D, D, kin(I_NPLEG), nullptr, WT_g, scr, cgw, cngw, lane); } }
    }
    SEAM(6);
    if (IN(7)) {
        pg8::SchedTiles S; S.init((const bf16*)(ws + WS_H), WT_ffo, T, D, FF, FF, G, bx);
        EpiFfnOut E{XB, (float*)(ws + WS_SSQ2)};
        pg8::gemm_phase<EpiFfnOut, pg8::SchedTiles, true>(lds, FF, FF, FF, S, E, tid);
    }
    SEAM(7);
    if (IN(8)) {
        pg8::SchedTiles S; S.init(XB, WT_g, T, D, D, D, G, bx);
        EpiPle E{(const float*)(ws + WS_SSQ2), kin(I_BG), (const bf16*)(ws + WS_PROJ), XB, args.out, (float*)(ws + WS_SSQ3)};
        pg8::gemm_phase<EpiPle, pg8::SchedTiles, true>(lds, D, D, D, S, E, tid);
    }
    SEAM(8);
    if (IN(9)) {
        const float* ssq3 = (const float*)(ws + WS_SSQ3);
        for (int m = gw; m < T; m += ngw) {
            float s = (lane < 32) ? ssq3[(size_t)m * 32 + lane] : 0.f; s = wave_sum(s);
            const float r = 1.0f / sqrtf(s * (1.0f / 2048.0f) + EPS);
            f32x4* xr = (f32x4*)(args.out + (size_t)m * D) + lane; const f32x4* gr = (const f32x4*)kin(I_FNG) + lane;
#pragma unroll
            for (int j = 0; j < 8; ++j) { const f32x4 v = xr[64 * j] * r * gr[64 * j]; xr[64 * j] = v; }
        }
    }
    STAMP(10);
    if (PROBE_PHASE >= 0 && bx == 0 && tid == 0) {
        const unsigned span = (PROBE_PHASE >= 100) ? MISC[24 + PROBE_PHASE - 100 + 1] - MISC[24 + PROBE_PHASE - 100] : MISC[12 + PROBE_PHASE + 1] - MISC[12 + PROBE_PHASE], t9 = MISC[12 + 10];
        while ((unsigned)__builtin_amdgcn_s_memrealtime() - t9 < span) __builtin_amdgcn_s_sleep(8);
    }
#undef IN
#undef SEAM
}

extern "C" void kernel_launch(void* const* d_in, const int* in_sizes, int n_in, void* d_out, int out_size, void* d_ws, size_t ws_size, hipStream_t stream) {
    static int grid = 0;
    if (grid == 0) {
        if (n_in != 29 || in_sizes[0] != T * D || out_size != T * D || ws_size < WS_END) {
            fprintf(stderr, "kernel_launch: shape/workspace mismatch: n_in %d in0 %d out %d ws %zu (need %zu); nothing launched\n", n_in, n_in > 0 ? in_sizes[0] : -1, out_size, ws_size, (size_t)WS_END); grid = -1; return; }
        int dev = 0, cus = 0, per_cu = 0;
        if (hipGetDevice(&dev) != hipSuccess || hipDeviceGetAttribute(&cus, hipDeviceAttributeMultiprocessorCount, dev) != hipSuccess) { fprintf(stderr, "kernel_launch: device query failed\n"); grid = -1; return; }
        if (hipFuncSetAttribute((const void*)hybrid_fwd, hipFuncAttributeMaxDynamicSharedMemorySize, LDS_BYTES) != hipSuccess) { fprintf(stderr, "kernel_launch: hipFuncSetAttribute failed\n"); grid = -1; return; }
        if (hipOccupancyMaxActiveBlocksPerMultiprocessor(&per_cu, (const void*)hybrid_fwd, NWAVES * 64, LDS_BYTES) != hipSuccess || per_cu < 1) { fprintf(stderr, "kernel_launch: occupancy query says %d blocks per CU; nothing launched\n", per_cu); (void)hipGetLastError(); grid = -1; return; }
        grid = cus;
        fprintf(stderr, "kernel_launch: grid %d (CUs %d, occupancy %d/CU), ws need %zu have %zu\n", grid, cus, per_cu, (size_t)WS_END, ws_size);
    }
    if (grid < 0) return;
    if (hipMemsetAsync((char*)d_ws + WS_CTL, 0, CTL_ZERO_BYTES, stream) != hipSuccess) { fprintf(stderr, "kernel_launch: memset failed\n"); return; }
    Args a{};
    for (int i = 0; i < 29; ++i) a.in[i] = (const float*)d_in[i];
    a.out = (float*)d_out; a.ws = (unsigned char*)d_ws;
    if (MK_N_LAUNCHES == 1) {
        a.ph_lo = 0; a.ph_hi = PER_PHASE; a.li = 0;
        void* kargs[] = {&a};
#ifdef PLAIN_LAUNCH
        (void)kargs; hipLaunchKernelGGL(hybrid_fwd, dim3(grid), dim3(NWAVES * 64), LDS_BYTES, stream, a);
        const hipError_t le = hipPeekAtLastError();
#else
        const hipError_t le = hipLaunchCooperativeKernel((const void*)hybrid_fwd, dim3(grid), dim3(NWAVES * 64), kargs, LDS_BYTES, stream);
#endif
        if (le != hipSuccess) fprintf(stderr, "kernel_launch: launch failed: %s (grid %d)\n", hipGetErrorName(le), grid);
    } else {
        for (int li = 0; li < PER_PHASE; ++li) {
            a.ph_lo = li; a.ph_hi = li + 1; a.li = 0;
            hipLaunchKernelGGL(hybrid_fwd, dim3(grid), dim3(NWAVES * 64), LDS_BYTES, stream, a);
            const hipError_t le = hipPeekAtLastError();
            if (le != hipSuccess) { fprintf(stderr, "kernel_launch: launch %d failed: %s\n", li, hipGetErrorName(le)); break; }
        }
    }
}
```

```cpp
#include <hip/hip_runtime.h>
#include <cstdio>
#include <cstdint>

#ifndef MK_N_LAUNCHES
#define MK_N_LAUNCHES 1
#endif

#define LAS __attribute__((address_space(3)))
#define GAS __attribute__((address_space(1)))
typedef unsigned short bf16;
typedef short bf16x8 __attribute__((ext_vector_type(8)));
typedef float f32x4 __attribute__((ext_vector_type(4)));
typedef float f32x2 __attribute__((ext_vector_type(2)));
typedef unsigned u32x4 __attribute__((ext_vector_type(4)));
typedef unsigned u32x2 __attribute__((ext_vector_type(2)));
typedef GAS unsigned gu32;

constexpr int T = 8192;
constexpr int SEQ = 4096;
constexpr int D = 2048, DS = 1024, DG = 1024, NIN = 3072, FF = 5632, PLE = 256;
constexpr int NG = 64, NP = 64, NH = 16;
constexpr int LC = 16;
constexpr int NCH = T / LC;
constexpr int KC = LC * NH + 2 * NP;
constexpr int KA = LC * NH;
constexpr float EPS = 1e-6f;

constexpr size_t MiB = 1u << 20;
constexpr size_t WS_CTL = 0, CTL_ZERO_BYTES = 64 * 1024;
constexpr size_t WS_WFFI = 1 * MiB;
constexpr size_t WS_WFFO = WS_WFFI + 44 * MiB;
constexpr size_t WS_WG   = WS_WFFO + 22 * MiB;
constexpr size_t WS_WPLE = WS_WG + 8 * MiB;
constexpr size_t WS_XB   = WS_WPLE + 1 * MiB;
constexpr size_t WS_PROJ = WS_XB + 32 * MiB;
constexpr size_t WS_SSQA = WS_PROJ + 32 * MiB;
constexpr size_t WS_SSQB = WS_SSQA + 1 * MiB;
constexpr size_t WS_SSQ1 = WS_SSQB + 1 * MiB;
constexpr size_t WS_SSQ2 = WS_SSQ1 + 1 * MiB;
constexpr size_t WS_SSQ3 = WS_SSQ2 + 1 * MiB;
constexpr size_t WS_LNST = WS_SSQ3 + 1 * MiB;
constexpr size_t WS_R0   = WS_LNST + 1 * MiB;
constexpr size_t WS_EARLY = WS_R0 + 1 * MiB;
constexpr size_t WS_WIN  = WS_EARLY;
constexpr size_t WS_WGLU = WS_WIN + 12 * MiB;
constexpr size_t WS_WOUT = WS_WGLU + 2 * MiB;
constexpr size_t WS_TF   = WS_WOUT + 8 * MiB;
constexpr size_t WS_E    = WS_TF + 12 * MiB;
constexpr size_t WS_A16  = WS_E + 5 * MiB;
constexpr size_t WS_AC   = WS_A16 + 1 * MiB;
constexpr size_t WS_GU   = WS_AC + 24 * MiB;
constexpr size_t WS_GV   = WS_GU + 16 * MiB;
constexpr size_t WS_SLOC = WS_GV + 16 * MiB;
constexpr size_t WS_YAPRE = WS_SLOC + 16 * MiB;
constexpr size_t WS_Y    = WS_YAPRE + 16 * MiB;
constexpr size_t WS_PB   = WS_Y + 32 * MiB;
constexpr size_t WS_EARLY_END = WS_PB + 4 * MiB;
constexpr size_t WS_H    = WS_EARLY;
constexpr size_t WS_END  = (WS_EARLY_END > WS_H + 88 * MiB) ? WS_EARLY_END : WS_H + 88 * MiB;

constexpr int CW_BAR = 4096;

constexpr int RING_BYTES = 131072;
constexpr int LDSCTL_OFF = RING_BYTES, MISC_OFF = LDSCTL_OFF + 320;
constexpr int LDS_BYTES = 147456;
constexpr int NWAVES = 8;

#define RLX_AGENT __ATOMIC_RELAXED, __HIP_MEMORY_SCOPE_AGENT
#define LDS_WAIT() asm volatile("s_waitcnt lgkmcnt(0)" ::: "memory")
#define VM_WAIT() asm volatile("s_waitcnt vmcnt(0)" ::: "memory")
__device__ __forceinline__ unsigned cvt_pk_bf16(float lo, float hi) { unsigned r; asm volatile("v_cvt_pk_bf16_f32 %0, %1, %2" : "=v"(r) : "v"(lo), "v"(hi)); return r; }
__device__ __forceinline__ float bf_lo(unsigned w) { return __uint_as_float(w << 16); }
__device__ __forceinline__ float bf_hi(unsigned w) { return __uint_as_float(w & 0xffff0000u); }
__device__ __forceinline__ float fast_sigmoid(float y) { return __builtin_amdgcn_rcpf(1.0f + __builtin_amdgcn_exp2f(-1.4426950408889634f * y)); }
__device__ __forceinline__ float gelu_tanh(float x) { const float y = 1.5957691216057308f * (x + 0.044715f * x * x * x); return x * fast_sigmoid(y); }
__device__ __forceinline__ float silu(float x) { return x * fast_sigmoid(x); }
__device__ __forceinline__ float wave_sum(float v) {
#pragma unroll
    for (int o = 1; o < 64; o <<= 1) v += __shfl_xor(v, o);
    return v;
}

namespace pg8 {
constexpr int BM = 256, BK = 64, HALF = 128, HTB = HALF * BK * 2, NXCD = 8, WGM = 8;
__host__ __device__ __forceinline__ int lds_byte(int r, int c) { const int st = (r >> 4) * 2 + (c >> 5), rr = r & 15, cc = c & 31, ob = rr * 64 + cc * 2; return st * 1024 + (ob ^ (((ob >> 9) & 1) << 5)); }
__host__ __device__ __forceinline__ void stage_rc(int b, int& R, int& C) { const int st = b / 1024, sb = b % 1024, swz = sb ^ (((sb >> 9) & 1) << 5); R = (st >> 1) * 16 + swz / 64; C = (st & 1) * 32 + (swz % 64) / 2; }
__host__ __device__ __forceinline__ int perm32(int rho) { const int n = rho >> 4, i = rho & 15; return 8 * (i >> 2) + 4 * n + (i & 3); }

struct Unit { const char* A; const char* B; int pm, pn, g; };

struct SchedTiles {
    const char* A; const char* B; size_t tstepA, tstepB; int nM, nN, nwg, G, c, pn0;
    __device__ __forceinline__ void init(const void* A_, const void* B_, int M, int N, int lda, int ldb, int G_, int c_, int pn0_ = 0) {
        pn0 = pn0_; A = (const char*)A_; B = (const char*)B_; tstepA = (size_t)BM * lda * 2; tstepB = (size_t)BM * ldb * 2; nM = M / BM; nN = N / BM; nwg = nM * nN; G = G_; c = c_; }
    __device__ __forceinline__ bool next(int i, Unit& u) const {
        const int L = i * G + c; if (L >= nwg) return false;
        int wgid = L; { const int q = nwg / NXCD, r = nwg % NXCD, xcd = wgid % NXCD, off = wgid / NXCD; wgid = (xcd < r ? xcd * (q + 1) : r * (q + 1) + (xcd - r) * q) + off; }
        const int nig = WGM * nN, gid = wgid / nig, fm = gid * WGM, gsz = (nM - fm) < WGM ? (nM - fm) : WGM;
        u.pm = fm + ((wgid % nig) % gsz); u.pn = (wgid % nig) / gsz; u.g = 0;
        u.A = A + (size_t)u.pm * tstepA; u.B = B + (size_t)u.pn * tstepB; u.pn += pn0; return true;
    }
};
struct SchedOne { Unit u; __device__ __forceinline__ bool next(int i, Unit& o) const { if (i != 0) return false; o = u; return true; } };

template <class Epi, class Sched, bool ALIGN_EPI>
__device__ __forceinline__ void gemm_phase(LAS unsigned char* lds, const int K, const int lda, const int ldb, const Sched& S, const Epi& E, int tid) {
    asm volatile("" : "+v"(tid));
    const int wid = __builtin_amdgcn_readfirstlane(tid >> 6), lane = tid & 63, wr = wid >> 2, wc = wid & 3, fr = lane & 15, fq = lane >> 4;
    const int nt = K / BK;
    unsigned voffA[2], voffB[2];
#pragma unroll
    for (int i = 0; i < 2; ++i) { int R, C; stage_rc(tid * 16 + i * 8192, R, C); const int Rb = (R & ~31) + perm32(R & 31);
        voffA[i] = (unsigned)(R * lda + C) * 2u; voffB[i] = (unsigned)(Rb * ldb + C) * 2u; }
    const size_t kstep = (size_t)(BK * 2);
    const size_t hstepA = (size_t)HALF * lda * 2, hstepB = (size_t)HALF * ldb * 2;
    const unsigned ldsw = (unsigned)wid * 1024u;
    const int aoff = lds_byte(wr * 64 + fr, fq * 8), boff = lds_byte(wc * 32 + fr, fq * 8);
#define PG8_SA(b, h) (((b) * 2 + (h)) * HTB)
#define PG8_SB(b, h) ((4 + (b) * 2 + (h)) * HTB)
#define PG8_STAGE(bufoff, gbase, voff) do { _Pragma("unroll") for (int _i = 0; _i < 2; ++_i) \
        __builtin_amdgcn_global_load_lds((const unsigned*)((const char*)(gbase) + (voff)[_i]), (LAS unsigned*)(lds + (bufoff) + ldsw + _i * 8192), 16, 0, 0); } while (0)
#define PG8_LDA(dst, b, h) do { _Pragma("unroll") for (int m = 0; m < 4; ++m) _Pragma("unroll") for (int k = 0; k < 2; ++k) dst[m][k] = *(const LAS bf16x8*)(lds + PG8_SA(b, h) + aoff + m * 2048 + k * 1024); } while (0)
#define PG8_LDB(dst, b, h) do { _Pragma("unroll") for (int n = 0; n < 2; ++n) _Pragma("unroll") for (int k = 0; k < 2; ++k) dst[n][k] = *(const LAS bf16x8*)(lds + PG8_SB(b, h) + boff + n * 2048 + k * 1024); } while (0)
#define PG8_MMA(ai, bj, At, Bt) do { __builtin_amdgcn_s_setprio(1); _Pragma("unroll") for (int m = 0; m < 4; ++m) _Pragma("unroll") for (int n = 0; n < 2; ++n) _Pragma("unroll") for (int k = 0; k < 2; ++k) \
        acc[ai][bj][m][n] = __builtin_amdgcn_mfma_f32_16x16x32_bf16(Bt[n][k], At[m][k], acc[ai][bj][m][n], 0, 0, 0); __builtin_amdgcn_s_setprio(0); } while (0)
#define PG8_WAIT_V(n) asm volatile("s_waitcnt vmcnt(" #n ")" ::: "memory")
#define PG8_WAIT_L(n) asm volatile("s_waitcnt lgkmcnt(" #n ")" ::: "memory")
#define PG8_BAR __builtin_amdgcn_s_barrier()
#define PG8_SCHED __builtin_amdgcn_sched_barrier(0)
    Unit cur, nxt; int ui = 0;
    if (!S.next(0, cur)) return;
    f32x4 acc[2][2][4][2];
#pragma unroll
    for (int a = 0; a < 2; ++a)
#pragma unroll
        for (int b = 0; b < 2; ++b)
#pragma unroll
            for (int m = 0; m < 4; ++m)
#pragma unroll
                for (int n = 0; n < 2; ++n) acc[a][b][m][n] = (f32x4){0.f, 0.f, 0.f, 0.f};
    bf16x8 At[4][2], B0[2][2], B1[2][2];
    const char* cA = cur.A; const char* cB = cur.B;
    PG8_STAGE(PG8_SB(0, 0), cB, voffB); PG8_STAGE(PG8_SB(0, 1), cB + hstepB, voffB); PG8_STAGE(PG8_SA(0, 0), cA, voffA); PG8_STAGE(PG8_SA(0, 1), cA + hstepA, voffA);
    if (wr == 1) PG8_BAR;
    PG8_WAIT_V(2); PG8_BAR;
    PG8_STAGE(PG8_SB(1, 0), cB + kstep, voffB); PG8_STAGE(PG8_SA(1, 0), cA + kstep, voffA); PG8_STAGE(PG8_SB(1, 1), cB + hstepB + kstep, voffB);
    PG8_WAIT_V(6); PG8_BAR;
    for (;;) {
        const bool has_next = S.next(ui + 1, nxt);
        const char* nA = has_next ? nxt.A : cA; const char* nB = has_next ? nxt.B : cB;
        for (int t = 0; t < nt; t += 2) {
            const bool last = (t == nt - 2);
            const char* a1 = cA + (size_t)(t + 1) * kstep;
            const char* a2 = last ? nA : cA + (size_t)(t + 2) * kstep; const char* b2 = last ? nB : cB + (size_t)(t + 2) * kstep;
            const char* a3 = a2 + kstep; const char* b3 = b2 + kstep;
            if constexpr (Epi::MID) { if (t == (nt >> 1)) E.mid(acc, cur, wr, wc, fr, fq); }
            PG8_LDB(B0, 0, 0); PG8_LDB(B1, 0, 1); PG8_SCHED; PG8_LDA(At, 0, 0); PG8_STAGE(PG8_SA(1, 1), a1 + hstepA, voffA);
            PG8_WAIT_V(8); PG8_WAIT_L(0); PG8_BAR; PG8_MMA(0, 0, At, B0); PG8_MMA(0, 1, At, B1); PG8_BAR; PG8_SCHED;
            PG8_LDA(At, 0, 1); PG8_STAGE(PG8_SB(0, 0), b2, voffB); PG8_STAGE(PG8_SB(0, 1), b2 + hstepB, voffB); PG8_STAGE(PG8_SA(0, 0), a2, voffA);
            PG8_WAIT_V(8); PG8_WAIT_L(0); PG8_BAR; PG8_MMA(1, 0, At, B0); PG8_MMA(1, 1, At, B1); PG8_BAR; PG8_SCHED;
            PG8_LDB(B0, 1, 0); PG8_LDB(B1, 1, 1); PG8_SCHED; PG8_LDA(At, 1, 0); PG8_STAGE(PG8_SA(0, 1), a2 + hstepA, voffA);
            PG8_WAIT_V(8); PG8_WAIT_L(0); PG8_BAR; PG8_MMA(0, 0, At, B0); PG8_MMA(0, 1, At, B1); PG8_BAR; PG8_SCHED;
            PG8_LDA(At, 1, 1); PG8_STAGE(PG8_SB(1, 0), b3, voffB); PG8_STAGE(PG8_SB(1, 1), b3 + hstepB, voffB); PG8_STAGE(PG8_SA(1, 0), a3, voffA);
            PG8_WAIT_V(8); PG8_WAIT_L(0); PG8_BAR; PG8_MMA(1, 0, At, B0); PG8_MMA(1, 1, At, B1); PG8_BAR; PG8_SCHED;
        }
        if constexpr (ALIGN_EPI) { if (wr == 0) PG8_BAR; }
        E(acc, cur, wr, wc, fr, fq);
        if (!has_next) break;
#pragma unroll
        for (int a = 0; a < 2; ++a)
#pragma unroll
            for (int b = 0; b < 2; ++b)
#pragma unroll
                for (int m = 0; m < 4; ++m)
#pragma unroll
                    for (int n = 0; n < 2; ++n) acc[a][b][m][n] = (f32x4){0.f, 0.f, 0.f, 0.f};
        cur = nxt; cA = nA; cB = nB; ++ui;
        if constexpr (ALIGN_EPI) { if (wr == 1) PG8_BAR; }
    }
    PG8_WAIT_V(0);
    if constexpr (!ALIGN_EPI) { if (wr == 0) PG8_BAR; }
    PG8_BAR;
#undef PG8_SA
#undef PG8_SB
#undef PG8_STAGE
#undef PG8_LDA
#undef PG8_LDB
#undef PG8_MMA
#undef PG8_WAIT_V
#undef PG8_WAIT_L
#undef PG8_BAR
#undef PG8_SCHED
}
}
using pg8::Unit;

#define EPI_ROWS(ai, m) _Pragma("unroll") for (int ai = 0; ai < 2; ++ai) _Pragma("unroll") for (int m = 0; m < 4; ++m)
typedef f32x4 acc_t[2][2][4][2];
#define EPI_FENCE(m) do { if ((m) & 1) asm volatile("" ::: "memory"); } while (0)

__device__ __forceinline__ u32x4 pack8(f32x4 v0, f32x4 v1) { u32x4 w; w.x = cvt_pk_bf16(v0[0], v0[1]); w.y = cvt_pk_bf16(v0[2], v0[3]); w.z = cvt_pk_bf16(v1[0], v1[1]); w.w = cvt_pk_bf16(v1[2], v1[3]); return w; }
__device__ __forceinline__ float sumsq8(f32x4 a, f32x4 b) { return ((a[0] * a[0] + a[1] * a[1]) + (a[2] * a[2] + a[3] * a[3])) + ((b[0] * b[0] + b[1] * b[1]) + (b[2] * b[2] + b[3] * b[3])); }
__device__ __forceinline__ float sum8(f32x4 a, f32x4 b) { return ((a[0] + a[1]) + (a[2] + a[3])) + ((b[0] + b[1]) + (b[2] + b[3])); }
__device__ __forceinline__ void unpack8(u32x4 w, f32x4& a, f32x4& b) { a = (f32x4){bf_lo(w.x), bf_hi(w.x), bf_lo(w.y), bf_hi(w.y)}; b = (f32x4){bf_lo(w.z), bf_hi(w.z), bf_lo(w.w), bf_hi(w.w)}; }
template <int NPART> __device__ __forceinline__ float row_partials(const float* base, int row, int fq) {
    float s;
    if constexpr (NPART == 32) { const f32x4 a = *(const f32x4*)(base + (size_t)row * 32 + 8 * fq), b = *(const f32x4*)(base + (size_t)row * 32 + 8 * fq + 4); s = sum8(a, b); }
    else if constexpr (NPART == 16) { const f32x4 a = *(const f32x4*)(base + (size_t)row * 16 + 4 * fq); s = (a[0] + a[1]) + (a[2] + a[3]); }
    else { const f32x2 a = *(const f32x2*)(base + (size_t)row * 8 + 2 * fq); s = a[0] + a[1]; }
    s += __shfl_xor(s, 16); s += __shfl_xor(s, 32); return s;
}

template <class Tv> __device__ __forceinline__ Tv ldg(const void* ubase, unsigned voff) { return *(const Tv*)((const char*)ubase + voff); }
template <class Tv> __device__ __forceinline__ void stg(void* ubase, unsigned voff, Tv v) { *(Tv*)((char*)ubase + voff) = v; }
template <int NPART> __device__ __forceinline__ float row_part2(const float* rbase, unsigned vo) {
    float s;
    if constexpr (NPART == 32) { const f32x4 a = ldg<f32x4>(rbase, vo), b = ldg<f32x4>(rbase, vo + 16); s = sum8(a, b); }
    else if constexpr (NPART == 16) { const f32x4 a = ldg<f32x4>(rbase, vo); s = (a[0] + a[1]) + (a[2] + a[3]); }
    else { const f32x2 a = ldg<f32x2>(rbase, vo); s = a[0] + a[1]; }
    s += __shfl_xor(s, 16); s += __shfl_xor(s, 32); return s;
}
struct EpiIn {
    static constexpr bool MID = false;
    const float* r0; bf16* AC; bf16* gu; bf16* gv; float* lnst;
    __device__ __forceinline__ void mid(acc_t&, const Unit&, int, int, int, int) const {}
    __device__ __forceinline__ void operator()(const acc_t& acc, const Unit& u, int wr, int wc, int fr, int fq) const {
        asm volatile("" : "+v"(fr), "+v"(fq));
        const int sect = u.pn >> 2;
        EPI_ROWS(ai, m) {
            const int row = u.pm * 256 + ai * 128 + wr * 64 + m * 16 + fr; const float rs = r0[row];
            float s1 = 0.f, s2 = 0.f;
#pragma unroll
            for (int bj = 0; bj < 2; ++bj) {
                const int col = u.pn * 256 + bj * 128 + wc * 32 + 8 * fq;
                f32x4 v0 = acc[ai][bj][m][0] * rs, v1 = acc[ai][bj][m][1] * rs;
                if (sect == 0) {
                    const int g = col >> 4, hi0 = col & 15, chunk = row >> 4, i = row & 15;
                    *(u32x4*)(AC + ((size_t)(g * NCH + chunk) * KC + i * 16 + hi0)) = pack8(v0, v1);
                } else {
#pragma unroll
                    for (int j = 0; j < 4; ++j) { v0[j] = gelu_tanh(v0[j]); v1[j] = gelu_tanh(v1[j]); }
                    if (sect == 1) *(u32x4*)(gu + (size_t)row * DG + (col - 1024)) = pack8(v0, v1);
                    else { *(u32x4*)(gv + (size_t)row * DG + (col - 2048)) = pack8(v0, v1); s1 += sum8(v0, v1); s2 += sumsq8(v0, v1); }
                }
            }
            if (sect == 2) {
                s1 += __shfl_xor(s1, 16); s1 += __shfl_xor(s1, 32); s2 += __shfl_xor(s2, 16); s2 += __shfl_xor(s2, 32);
                if (fq == 0) *(f32x2*)(lnst + ((size_t)row * 16 + (u.pn - 8) * 4 + wc) * 2) = (f32x2){s1, s2};
            }
        }
    }
};
struct EpiSloc {
    static constexpr bool MID = false;
    float* sloc;
    __device__ __forceinline__ void mid(acc_t&, const Unit&, int, int, int, int) const {}
    __device__ __forceinline__ void operator()(const acc_t& acc, const Unit& u, int wr, int wc, int fr, int fq) const {
        asm volatile("" : "+v"(fr), "+v"(fq));
        EPI_ROWS(ai, m) {
            const int row = u.pm * 256 + ai * 128 + wr * 64 + m * 16 + fr;
            float* o = sloc + ((size_t)(u.g * NCH + row) * 128 + wc * 32 + 8 * fq);
            *(f32x4*)o = acc[ai][0][m][0]; *(f32x4*)(o + 4) = acc[ai][0][m][1];
        }
    }
};
struct EpiS5Out {
    static constexpr bool MID = false;
    const bf16* AC; const float* dvec; bf16* yapre;
    __device__ __forceinline__ void mid(acc_t&, const Unit&, int, int, int, int) const {}
    __device__ __forceinline__ void operator()(const acc_t& acc, const Unit& u, int wr, int wc, int fr, int fq) const {
        asm volatile("" : "+v"(fr), "+v"(fq));
        const int ho0 = 8 * (fq & 1);
        const f32x4 d0 = *(const f32x4*)(dvec + u.g * 16 + ho0), d1 = *(const f32x4*)(dvec + u.g * 16 + ho0 + 4);
        const unsigned vin = (unsigned)(((wr * 64 + fr) * KC + (2 * wc + (fq >> 1)) * 16 + ho0) * 2);
        const unsigned vout = (unsigned)((((wr * 64 + fr) * LC + 2 * wc + (fq >> 1)) * DS + ho0) * 2);
        const bf16* ib = AC + (size_t)(u.g * NCH + u.pm * 256) * KC; bf16* ob = yapre + (size_t)u.pm * 256 * LC * DS + u.g * 16;
        u32x4 uw[2][4][2];
        EPI_ROWS(ai, m) {
#pragma unroll
            for (int bj = 0; bj < 2; ++bj) uw[ai][m][bj] = ldg<u32x4>(ib + (size_t)(ai * 128 + m * 16) * KC + bj * 128, vin);
        }
        EPI_ROWS(ai, m) {
#pragma unroll
            for (int bj = 0; bj < 2; ++bj) {
                f32x4 u0, u1; unpack8(uw[ai][m][bj], u0, u1);
                f32x4 v0 = acc[ai][bj][m][0] + d0 * u0, v1 = acc[ai][bj][m][1] + d1 * u1;
#pragma unroll
                for (int q = 0; q < 4; ++q) { v0[q] = gelu_tanh(v0[q]); v1[q] = gelu_tanh(v1[q]); }
                stg<u32x4>(ob + ((size_t)(ai * 128 + m * 16) * LC + 8 * bj) * DS, vout, pack8(v0, v1));
            }
        }
    }
};
struct EpiGlu {
    static constexpr bool MID = false;
    const bf16* yapre; const float* bias; bf16* Y; float* ssqa;
    __device__ __forceinline__ void mid(acc_t&, const Unit&, int, int, int, int) const {}
    __device__ __forceinline__ void operator()(const acc_t& acc, const Unit& u, int wr, int wc, int fr, int fq) const {
        asm volatile("" : "+v"(fr), "+v"(fq));
        const unsigned vin = (unsigned)(((wr * 64 + fr) * DS + wc * 32 + 8 * fq) * 2), vout = (unsigned)(((wr * 64 + fr) * D + wc * 32 + 8 * fq) * 2);
        const unsigned vcol = (unsigned)((wc * 32 + 8 * fq) * 4), vss = (unsigned)(((wr * 64 + fr) * 16 + wc) * 4);
        const bf16* ib = yapre + (size_t)u.pm * 256 * DS + u.pn * 256; bf16* ob = Y + (size_t)u.pm * 256 * D + u.pn * 256; float* sbp = ssqa + (size_t)u.pm * 256 * 16 + u.pn * 4;
        f32x4 bv[2][2]; u32x4 yw[2][4][2];
        EPI_ROWS(ai, m) {
#pragma unroll
            for (int bj = 0; bj < 2; ++bj) yw[ai][m][bj] = ldg<u32x4>(ib + (size_t)(ai * 128 + m * 16) * DS + bj * 128, vin);
        }
#pragma unroll
        for (int bj = 0; bj < 2; ++bj) { bv[bj][0] = ldg<f32x4>(bias + u.pn * 256 + bj * 128, vcol); bv[bj][1] = ldg<f32x4>(bias + u.pn * 256 + bj * 128 + 4, vcol); }
        EPI_ROWS(ai, m) {
            float ss = 0.f;
#pragma unroll
            for (int bj = 0; bj < 2; ++bj) {
                f32x4 y0, y1; unpack8(yw[ai][m][bj], y0, y1);
                f32x4 v0 = acc[ai][bj][m][0] + bv[bj][0], v1 = acc[ai][bj][m][1] + bv[bj][1];
#pragma unroll
                for (int q = 0; q < 4; ++q) { v0[q] = y0[q] * fast_sigmoid(v0[q]); v1[q] = y1[q] * fast_sigmoid(v1[q]); }
                ss += sumsq8(v0, v1);
                stg<u32x4>(ob + (size_t)(ai * 128 + m * 16) * D + bj * 128, vout, pack8(v0, v1));
            }
            ss += __shfl_xor(ss, 16); ss += __shfl_xor(ss, 32);
            if (fq == 0) stg<float>(sbp + (size_t)(ai * 128 + m * 16) * 16, vss, ss);
        }
    }
};
struct EpiProj {
    static constexpr bool MID = false;
    bf16* proj;
    __device__ __forceinline__ void mid(acc_t&, const Unit&, int, int, int, int) const {}
    __device__ __forceinline__ void operator()(const acc_t& acc, const Unit& u, int wr, int wc, int fr, int fq) const {
        asm volatile("" : "+v"(fr), "+v"(fq));
        EPI_ROWS(ai, m) {
            const int row = u.pm * 256 + ai * 128 + wr * 64 + m * 16 + fr;
#pragma unroll
            for (int bj = 0; bj < 2; ++bj) { const int col = u.pn * 256 + bj * 128 + wc * 32 + 8 * fq; *(u32x4*)(proj + (size_t)row * D + col) = pack8(acc[ai][bj][m][0], acc[ai][bj][m][1]); }
        }
    }
};
struct EpiOut {
    static constexpr bool MID = true;
    const float* ssqa; const float* ssqb; bf16* xb; float* ssq1;
    __device__ __forceinline__ void mid(acc_t& acc, const Unit& u, int wr, int wc, int fr, int fq) const {
        asm volatile("" : "+v"(fr), "+v"(fq));
        const unsigned va = (unsigned)(((wr * 64 + fr) * 16 + 4 * fq) * 4), vb = (unsigned)(((wr * 64 + fr) * 8 + 2 * fq) * 4);
        const float* ab = ssqa + (size_t)u.pm * 256 * 16; const float* bb = ssqb + (size_t)u.pm * 256 * 8;
        float sa[2][4], sb[2][4];
        EPI_ROWS(ai, m) { sa[ai][m] = row_part2<16>(ab + (size_t)(ai * 128 + m * 16) * 16, va); sb[ai][m] = row_part2<8>(bb + (size_t)(ai * 128 + m * 16) * 8, vb); }
        EPI_ROWS(ai, m) {
            const float ratio = sqrtf((sb[ai][m] * (1.0f / 1024.0f) + EPS) / (sa[ai][m] * (1.0f / 1024.0f) + EPS));
#pragma unroll
            for (int bj = 0; bj < 2; ++bj) { acc[ai][bj][m][0] *= ratio; acc[ai][bj][m][1] *= ratio; }
        }
    }
    __device__ __forceinline__ void operator()(const acc_t& acc, const Unit& u, int wr, int wc, int fr, int fq) const {
        asm volatile("" : "+v"(fr), "+v"(fq));
        const unsigned vx = (unsigned)(((wr * 64 + fr) * D + wc * 32 + 8 * fq) * 2), vb = (unsigned)(((wr * 64 + fr) * 8 + 2 * fq) * 4), vss = (unsigned)(((wr * 64 + fr) * 32 + wc) * 4);
        bf16* xt = xb + (size_t)u.pm * 256 * D + u.pn * 256; const float* bb = ssqb + (size_t)u.pm * 256 * 8; float* sp = ssq1 + (size_t)u.pm * 256 * 32 + u.pn * 4;
        u32x4 xw[2][4][2]; float sb[2][4];
        EPI_ROWS(ai, m) {
#pragma unroll
            for (int bj = 0; bj < 2; ++bj) xw[ai][m][bj] = ldg<u32x4>(xt + (size_t)(ai * 128 + m * 16) * D + bj * 128, vx);
            sb[ai][m] = row_part2<8>(bb + (size_t)(ai * 128 + m * 16) * 8, vb);
        }
        EPI_ROWS(ai, m) {
            const float rb = 1.0f / sqrtf(sb[ai][m] * (1.0f / 1024.0f) + EPS); float ss = 0.f;
#pragma unroll
            for (int bj = 0; bj < 2; ++bj) {
                f32x4 x0, x1; unpack8(xw[ai][m][bj], x0, x1);
                const f32x4 v0 = x0 + acc[ai][bj][m][0] * rb, v1 = x1 + acc[ai][bj][m][1] * rb;
                stg<u32x4>(xt + (size_t)(ai * 128 + m * 16) * D + bj * 128, vx, pack8(v0, v1)); ss += sumsq8(v0, v1);
            }
            ss += __shfl_xor(ss, 16); ss += __shfl_xor(ss, 32);
            if (fq == 0) stg<float>(sp + (size_t)(ai * 128 + m * 16) * 32, vss, ss);
        }
    }
};
struct EpiFfnIn {
    static constexpr bool MID = false;
    const float* ssq1; bf16* h;
    __device__ __forceinline__ void mid(acc_t&, const Unit&, int, int, int, int) const {}
    __device__ __forceinline__ void operator()(const acc_t& acc, const Unit& u, int wr, int wc, int fr, int fq) const {
        asm volatile("" : "+v"(fr), "+v"(fq));
        const unsigned vs = (unsigned)(((wr * 64 + fr) * 32 + 8 * fq) * 4), vh = (unsigned)(((wr * 64 + fr) * FF + wc * 32 + 8 * fq) * 2);
        const float* sp = ssq1 + (size_t)u.pm * 256 * 32; bf16* hb = h + (size_t)u.pm * 256 * FF + u.pn * 128;
        float s1[2][4];
        EPI_ROWS(ai, m) s1[ai][m] = row_part2<32>(sp + (size_t)(ai * 128 + m * 16) * 32, vs);
        EPI_ROWS(ai, m) {
            const float r1 = 1.0f / sqrtf(s1[ai][m] * (1.0f / 2048.0f) + EPS);
            f32x4 g0 = acc[ai][0][m][0] * r1, g1 = acc[ai][0][m][1] * r1; const f32x4 u0 = acc[ai][1][m][0] * r1, u1 = acc[ai][1][m][1] * r1;
#pragma unroll
            for (int q = 0; q < 4; ++q) { g0[q] = silu(g0[q]) * u0[q]; g1[q] = silu(g1[q]) * u1[q]; }
            stg<u32x4>(hb + (size_t)(ai * 128 + m * 16) * FF, vh, pack8(g0, g1));
        }
    }
};
struct EpiFfnOut {
    static constexpr bool MID = false;
    bf16* xb; float* ssq2;
    __device__ __forceinline__ void mid(acc_t&, const Unit&, int, int, int, int) const {}
    __device__ __forceinline__ void operator()(const acc_t& acc, const Unit& u, int wr, int wc, int fr, int fq) const {
        asm volatile("" : "+v"(fr), "+v"(fq));
        const unsigned vx = (unsigned)(((wr * 64 + fr) * D + wc * 32 + 8 * fq) * 2), vss = (unsigned)(((wr * 64 + fr) * 32 + wc) * 4);
        bf16* xt = xb + (size_t)u.pm * 256 * D + u.pn * 256; float* sp = ssq2 + (size_t)u.pm * 256 * 32 + u.pn * 4;
        u32x4 xw[2][4][2];
        EPI_ROWS(ai, m) {
#pragma unroll
            for (int bj = 0; bj < 2; ++bj) xw[ai][m][bj] = ldg<u32x4>(xt + (size_t)(ai * 128 + m * 16) * D + bj * 128, vx);
        }
        EPI_ROWS(ai, m) {
            float ss = 0.f;
#pragma unroll
            for (int bj = 0; bj < 2; ++bj) {
                f32x4 x0, x1; unpack8(xw[ai][m][bj], x0, x1);
                const f32x4 v0 = x0 + acc[ai][bj][m][0], v1 = x1 + acc[ai][bj][m][1];
                stg<u32x4>(xt + (size_t)(ai * 128 + m * 16) * D + bj * 128, vx, pack8(v0, v1)); ss += sumsq8(v0, v1);
            }
            ss += __shfl_xor(ss, 16); ss += __shfl_xor(ss, 32);
            if (fq == 0) stg<float>(sp + (size_t)(ai * 128 + m * 16) * 32, vss, ss);
        }
    }
};
struct EpiPle {
    static constexpr bool MID = false;
    const float* ssq2; const float* bias; const bf16* proj; const bf16* xb; float* xo; float* ssq3;
    __device__ __forceinline__ void mid(acc_t&, const Unit&, int, int, int, int) const {}
    __device__ __forceinline__ void operator()(const acc_t& acc, const Unit& u, int wr, int wc, int fr, int fq) const {
        asm volatile("" : "+v"(fr), "+v"(fq));
        const unsigned vx = (unsigned)(((wr * 64 + fr) * D + wc * 32 + 8 * fq) * 2), vo = 2 * vx, vs = (unsigned)(((wr * 64 + fr) * 32 + 8 * fq) * 4), vss = (unsigned)(((wr * 64 + fr) * 32 + wc) * 4);
        const unsigned vcol = (unsigned)((wc * 32 + 8 * fq) * 4);
        const size_t toff = (size_t)u.pm * 256 * D + u.pn * 256;
        const bf16* xt = xb + toff; const bf16* pt = proj + toff; float* ot = xo + toff; const float* s2p = ssq2 + (size_t)u.pm * 256 * 32; float* sp = ssq3 + (size_t)u.pm * 256 * 32 + u.pn * 4;
        f32x4 bv[2][2];
#pragma unroll
        for (int bj = 0; bj < 2; ++bj) { bv[bj][0] = ldg<f32x4>(bias + u.pn * 256 + bj * 128, vcol); bv[bj][1] = ldg<f32x4>(bias + u.pn * 256 + bj * 128 + 4, vcol); }
        float s2a[2][4];
        EPI_ROWS(ai, m) s2a[ai][m] = row_part2<32>(s2p + (size_t)(ai * 128 + m * 16) * 32, vs);
        asm volatile("" ::: "memory");
#pragma unroll
        for (int ai = 0; ai < 2; ++ai)
#pragma unroll
        for (int mp = 0; mp < 2; ++mp) {
            u32x4 xw[2][2], pw[2][2];
#pragma unroll
            for (int mm = 0; mm < 2; ++mm) { const int m = 2 * mp + mm;
#pragma unroll
                for (int bj = 0; bj < 2; ++bj) { xw[mm][bj] = ldg<u32x4>(xt + (size_t)(ai * 128 + m * 16) * D + bj * 128, vx); pw[mm][bj] = ldg<u32x4>(pt + (size_t)(ai * 128 + m * 16) * D + bj * 128, vx); }
            }
#pragma unroll
            for (int mm = 0; mm < 2; ++mm) { const int m = 2 * mp + mm;
                const float r2 = 1.0f / sqrtf(s2a[ai][m] * (1.0f / 2048.0f) + EPS); float ss = 0.f;
#pragma unroll
                for (int bj = 0; bj < 2; ++bj) {
                    f32x4 p0, p1, x0, x1; unpack8(pw[mm][bj], p0, p1); unpack8(xw[mm][bj], x0, x1);
                    f32x4 v0 = acc[ai][bj][m][0] * r2 + bv[bj][0], v1 = acc[ai][bj][m][1] * r2 + bv[bj][1];
#pragma unroll
                    for (int q = 0; q < 4; ++q) { v0[q] = x0[q] + fast_sigmoid(v0[q]) * p0[q]; v1[q] = x1[q] + fast_sigmoid(v1[q]) * p1[q]; }
                    float* op = ot + (size_t)(ai * 128 + m * 16) * D + bj * 128;
                    stg<f32x4>(op, vo, v0); stg<f32x4>(op + 4, vo, v1); ss += sumsq8(v0, v1);
                }
                ss += __shfl_xor(ss, 16); ss += __shfl_xor(ss, 32);
                if (fq == 0) stg<float>(sp + (size_t)(ai * 128 + m * 16) * 32, vss, ss);
            }
            asm volatile("" ::: "memory");
        }
    }
};

#define XB_TMO      128
#define XB_XCNT(j)  (256  + 64 * (j))
#define XB_XSUB(j)  (1280 + 64 * (j))
#define XB_XGEN(j)  (2304 + 64 * (j))
#define XB_TOP      3328
#define XB_TOPGEN   3392
#define XCD_BAR_WORDS 3456
#define XB_SPIN_CAP (1u << 18)
__device__ __forceinline__ unsigned xb_ld(unsigned* p)              { return __hip_atomic_load(p, __ATOMIC_RELAXED, __HIP_MEMORY_SCOPE_AGENT); }
__device__ __forceinline__ unsigned xb_add(unsigned* p, unsigned v) { return __hip_atomic_fetch_add(p, v, __ATOMIC_RELAXED, __HIP_MEMORY_SCOPE_AGENT); }
__device__ __forceinline__ unsigned xb_xcc_id() { return (unsigned)__builtin_amdgcn_s_getreg((3 << 11) | 20) & 0xFu; }
#define XB_SPIN(cond, bar) do { unsigned _sp = 0; while (cond) { __builtin_amdgcn_s_sleep(1); \
    if ((++_sp & 255u) == 0u) { if (xb_ld(&(bar)[XB_TMO])) break; if (_sp > XB_SPIN_CAP) { atomicAdd(&(bar)[XB_TMO], 1u); break; } } } } while (0)
struct XcdBarrier { unsigned* bar; unsigned x; volatile LAS unsigned* st; };
__device__ __forceinline__ XcdBarrier xcd_barrier_post(unsigned* bar, volatile LAS unsigned* st) {
    XcdBarrier b; b.bar = bar; b.x = xb_xcc_id(); b.st = st;
    if (threadIdx.x == 0) (void)xb_add(&bar[XB_XCNT(b.x)], 1u);
    return b;
}
__device__ __forceinline__ void xcd_barrier_complete(unsigned* bar, unsigned x, unsigned& nloc, unsigned& nx) {
    const unsigned G = gridDim.x * gridDim.y * gridDim.z;
    unsigned sum, cnt, mine, sp = 0u;
    for (;;) {
        sum = 0u; cnt = 0u; mine = 0u;
#pragma unroll
        for (unsigned j = 0; j < 16; ++j) { const unsigned c = xb_ld(&bar[XB_XCNT(j)]); sum += c; cnt += (c > 0u) ? 1u : 0u; mine = (j == x) ? c : mine; }
        if (sum == G) break;
        __builtin_amdgcn_s_sleep(1);
        if ((++sp & 255u) == 0u) { if (xb_ld(&bar[XB_TMO])) break; if (sp > XB_SPIN_CAP) { atomicAdd(&bar[XB_TMO], 1u); break; } }
    }
    nloc = mine > 0u ? mine : 1u; nx = cnt > 0u ? cnt : 1u;
}
__device__ __forceinline__ void xcd_barrier(const XcdBarrier& b) {
    asm volatile("s_waitcnt vmcnt(0)" ::: "memory");
    __syncthreads();
    if (threadIdx.x == 0) {
        unsigned* bar = b.bar;
        __builtin_amdgcn_s_waitcnt(0);
        unsigned nloc = b.st[0], nx = b.st[1];
        if (nloc == 0u) { xcd_barrier_complete(bar, b.x, nloc, nx); b.st[0] = nloc; b.st[1] = nx; }
        const unsigned old = xb_add(&bar[XB_XSUB(b.x)], 1u);
        const unsigned gen = old / nloc;
        if (old + 1u == (gen + 1u) * nloc) {
            __builtin_amdgcn_fence(__ATOMIC_RELEASE, "agent");
            asm volatile("s_waitcnt vmcnt(0)" ::: "memory");
            const unsigned og = xb_add(&bar[XB_TOP], 1u);
            const unsigned tg = og / nx;
            if (og + 1u == (tg + 1u) * nx) xb_add(&bar[XB_TOPGEN], 1u);
            else XB_SPIN(xb_ld(&bar[XB_TOPGEN]) == tg, bar);
            __builtin_amdgcn_fence(__ATOMIC_ACQUIRE, "agent");
            xb_add(&bar[XB_XGEN(b.x)], 1u);
            asm volatile("s_waitcnt vmcnt(0)" ::: "memory");
        } else {
            XB_SPIN(xb_ld(&bar[XB_XGEN(b.x)]) == gen, bar);
            __builtin_amdgcn_fence(__ATOMIC_ACQUIRE, "agent");
            asm volatile("s_waitcnt vmcnt(0)" ::: "memory");
        }
    }
    __syncthreads();
}

struct Args { const float* in[29]; float* out; unsigned char* ws; int ph_lo, ph_hi, li, pad; };
enum In { I_X = 0, I_P, I_NMIXG, I_WIN, I_LRE, I_LIM, I_LSTEP, I_BRE, I_BIM, I_CRE, I_CIM, I_SD, I_GLUW, I_GLUB, I_LNG, I_LNB, I_SGUW, I_SGUB,
          I_ONSSM, I_ONSGU, I_WOUT, I_NFFNG, I_WFFI, I_WFFO, I_NPLEG, I_WG, I_BG, I_WPLE, I_FNG };

__device__ __forceinline__ const float* kin(int i) {
    int off = i * 8; asm volatile("" : "+s"(off));
    return *(const float* const*)((const char*)__builtin_amdgcn_kernarg_segment_ptr() + off);
}
__device__ __forceinline__ void p0_transpose_item(const float* W, int N, const float* gain, bf16* WT, int ldt, int dst_row0, int k0, int n0, LAS float* scr, int lane) {
    float v[32];
    const float* src = W + (size_t)(k0 + (lane >> 5)) * N + n0 + (lane & 31);
#pragma unroll
    for (int i = 0; i < 32; ++i) v[i] = src[(size_t)(2 * i) * N];
    if (gain) {
#pragma unroll
        for (int i = 0; i < 32; ++i) v[i] *= gain[k0 + 2 * i + (lane >> 5)];
    }
#pragma unroll
    for (int i = 0; i < 32; ++i) scr[(2 * i + (lane >> 5)) * 33 + (lane & 31)] = v[i];
    LDS_WAIT(); asm volatile("" ::: "memory");
    const int c = lane & 7;
#pragma unroll
    for (int j = 0; j < 4; ++j) { const int n = (lane >> 3) + 8 * j; const LAS float* s = scr + (8 * c) * 33 + n;
        u32x4 o; o.x = cvt_pk_bf16(s[0 * 33], s[1 * 33]); o.y = cvt_pk_bf16(s[2 * 33], s[3 * 33]); o.z = cvt_pk_bf16(s[4 * 33], s[5 * 33]); o.w = cvt_pk_bf16(s[6 * 33], s[7 * 33]);
        *(u32x4*)(WT + (size_t)(dst_row0 + n) * ldt + k0 + 8 * c) = o; }
    LDS_WAIT(); asm volatile("" ::: "memory");
}
template <int MODE>
__device__ __forceinline__ void p0_transpose(const float* W, int K, int N, const float* gain, const float* gain2, bf16* WT, LAS float* scr, int gw, int ngw, int lane) {
    const int nblk = N / 32, nitems = (K / 64) * nblk;
    for (int it = gw; it < nitems; it += ngw) {
        const int kb = it / nblk, nb = it % nblk, k0 = 64 * kb, n0 = 32 * nb;
        int dst = n0;
        if (MODE == 1) { const int half = (n0 >= FF) ? 1 : 0, j = n0 - half * FF; dst = 256 * (j >> 7) + 128 * half + (j & 127); }
        const float* g = gain; if (gain2 && k0 >= 1024) g = gain2 - 1024;
        p0_transpose_item(W, N, g, WT, K, dst, k0, n0, scr, lane);
    }
}
__device__ __forceinline__ void p0_s5_tables(const Args& a, int g, LAS float* L, int tid) {
    constexpr int PS = 66, KS = 260;
    LAS float* apow = L;
    LAS float* Bb = L + 2244;
    LAS float* Cc = Bb + 2048;
    LAS float* Kk = Cc + 2112;
    LAS float* qq = Kk + 4160;
    bf16* TF = (bf16*)(a.ws + WS_TF) + (size_t)g * 256 * KC;
    bf16* E = (bf16*)(a.ws + WS_E) + (size_t)g * 128 * KA;
    float* A16 = (float*)(a.ws + WS_A16) + (size_t)g * NP * 2;
    { const float* bre = kin(I_BRE) + (size_t)g * NP * NH; const float* bim = kin(I_BIM) + (size_t)g * NP * NH; const float* cre = kin(I_CRE) + (size_t)g * NH * NP; const float* cim = kin(I_CIM) + (size_t)g * NH * NP;
      for (int e = tid; e < NP * NH; e += 512) { Bb[e * 2] = bre[e]; Bb[e * 2 + 1] = bim[e]; { const int ce = (e >> 6) * PS + (e & 63); Cc[ce * 2] = cre[e]; Cc[ce * 2 + 1] = cim[e]; } } }
    if (tid < NP) {
        const int p = tid;
        const double lr = fmin((double)kin(I_LRE)[g * NP + p], -1e-4), li = (double)kin(I_LIM)[g * NP + p];
        const double dt = exp((double)kin(I_LSTEP)[g]);
        const double mg = exp(lr * dt); double sn, cs; sincos(li * dt, &sn, &cs);
        { const double a1r = mg * cs, a1i = mg * sn; double pr = 1.0, pi = 0.0;
#pragma unroll
          for (int k = 0; k <= LC; ++k) { apow[(k * PS + p) * 2] = (float)pr; apow[(k * PS + p) * 2 + 1] = (float)pi; if (k == LC) { A16[p * 2] = (float)pr; A16[p * 2 + 1] = (float)pi; } const double nr = pr * a1r - pi * a1i, ni = pr * a1i + pi * a1r; pr = nr; pi = ni; } }
        const double nr = mg * cs - 1.0, ni = mg * sn, den = lr * lr + li * li;
        qq[p * 2] = (float)((nr * lr + ni * li) / den); qq[p * 2 + 1] = (float)((ni * lr - nr * li) / den);
    }
    __syncthreads();
    for (int e = tid; e < NP * NH; e += 512) { const int p = e >> 4; const float qr = qq[p * 2], qi = qq[p * 2 + 1], br = Bb[e * 2], bi = Bb[e * 2 + 1]; Bb[e * 2] = qr * br - qi * bi; Bb[e * 2 + 1] = qr * bi + qi * br; }
    __syncthreads();
    {
        const int kh = tid >> 1, k = kh >> 4, ho = kh & 15, hi0 = 8 * (tid & 1); float s8[8];
#pragma unroll
        for (int q = 0; q < 8; ++q) s8[q] = 0.f;
#pragma unroll 4
        for (int p = 0; p < NP; ++p) {
            const f32x2 c = *(const LAS f32x2*)(Cc + (ho * PS + p) * 2), av = *(const LAS f32x2*)(apow + (k * PS + p) * 2);
            const float zr = c[0] * av[0] - c[1] * av[1], zi = c[0] * av[1] + c[1] * av[0];
#pragma unroll
            for (int q = 0; q < 8; q += 2) { const f32x4 b = *(const LAS f32x4*)(Bb + (p * NH + hi0 + q) * 2); s8[q] += zr * b[0] - zi * b[1]; s8[q + 1] += zr * b[2] - zi * b[3]; }
        }
#pragma unroll
        for (int q = 0; q < 8; ++q) Kk[k * KS + ho * 16 + hi0 + q] = s8[q];
    }
    __syncthreads();
    for (int e = tid; e < 256 * 48; e += 512) {
        const int row = e / 48, pc = e % 48, j = row >> 4, ho = row & 15; float v[8];
        if (pc < 32) { const int i = pc >> 1, hi = (pc & 1) * 8;
            if (i <= j) { const f32x4 k0 = *(const LAS f32x4*)(Kk + (j - i) * KS + ho * 16 + hi), k1 = *(const LAS f32x4*)(Kk + (j - i) * KS + ho * 16 + hi + 4);
#pragma unroll
                for (int q = 0; q < 4; ++q) { v[q] = k0[q]; v[4 + q] = k1[q]; } }
            else {
#pragma unroll
                for (int q = 0; q < 8; ++q) v[q] = 0.f; }
        } else { const int pp = (pc - 32) * 8, ri = pp >> 6, p0 = pp & 63;
#pragma unroll
            for (int q = 0; q < 8; q += 2) { const f32x4 c = *(const LAS f32x4*)(Cc + (ho * PS + p0 + q) * 2), av = *(const LAS f32x4*)(apow + ((j + 1) * PS + p0 + q) * 2);
                v[q] = ri == 0 ? (c[0] * av[0] - c[1] * av[1]) : -(c[0] * av[1] + c[1] * av[0]); v[q + 1] = ri == 0 ? (c[2] * av[2] - c[3] * av[3]) : -(c[2] * av[3] + c[3] * av[2]); } }
        u32x4 o; o.x = cvt_pk_bf16(v[0], v[1]); o.y = cvt_pk_bf16(v[2], v[3]); o.z = cvt_pk_bf16(v[4], v[5]); o.w = cvt_pk_bf16(v[6], v[7]);
        *(u32x4*)(TF + (size_t)row * KC + pc * 8) = o;
    }
    for (int e = tid; e < 128 * 32; e += 512) {
        const int row = e >> 5, pc = e & 31, ri = row >> 6, p = row & 63, i = pc >> 1, hi = (pc & 1) * 8; float v[8];
        const f32x2 av = *(const LAS f32x2*)(apow + ((LC - 1 - i) * PS + p) * 2);
#pragma unroll
        for (int q = 0; q < 8; q += 2) { const f32x4 b = *(const LAS f32x4*)(Bb + (p * NH + hi + q) * 2);
            v[q] = ri == 0 ? (av[0] * b[0] - av[1] * b[1]) : (av[0] * b[1] + av[1] * b[0]); v[q + 1] = ri == 0 ? (av[0] * b[2] - av[1] * b[3]) : (av[0] * b[3] + av[1] * b[2]); }
        u32x4 o; o.x = cvt_pk_bf16(v[0], v[1]); o.y = cvt_pk_bf16(v[2], v[3]); o.z = cvt_pk_bf16(v[4], v[5]); o.w = cvt_pk_bf16(v[6], v[7]);
        *(u32x4*)(E + (size_t)row * KA + pc * 8) = o;
    }
    __syncthreads();
}

__device__ __forceinline__ void s5_scan(const Args& a, int g, int b, LAS unsigned char* lds, int wave, int lane) {
    asm volatile("" : "+v"(lane));
    const float* sloc = (const float*)(a.ws + WS_SLOC) + (size_t)(g * NCH + b * 256 + wave * 32) * 128;
    bf16* AC = (bf16*)(a.ws + WS_AC) + (size_t)(g * NCH + b * 256 + wave * 32) * KC + 256;
    const float* A16 = (const float*)(a.ws + WS_A16) + (size_t)g * NP * 2;
    const float ar = A16[lane * 2], ai = A16[lane * 2 + 1];
    float xr[32], xi[32];
#pragma unroll
    for (int j = 0; j < 32; ++j) { xr[j] = sloc[j * 128 + lane]; xi[j] = sloc[j * 128 + 64 + lane]; }
    float sr = 0.f, si = 0.f;
#pragma unroll
    for (int j = 0; j < 32; ++j) { const float nr = ar * sr - ai * si + xr[j], ni = ar * si + ai * sr + xi[j]; sr = nr; si = ni; }
    LAS float* ex = (LAS float*)lds;
    ex[(wave * 64 + lane) * 2] = sr; ex[(wave * 64 + lane) * 2 + 1] = si;
    float pr = ar, pi = ai;
#pragma unroll
    for (int q = 0; q < 5; ++q) { const float nr = pr * pr - pi * pi, ni = 2.f * pr * pi; pr = nr; pi = ni; }
    __syncthreads();
    float cr = 0.f, ci = 0.f;
    for (int v = 0; v < wave; ++v) { const float er = ex[(v * 64 + lane) * 2], ei = ex[(v * 64 + lane) * 2 + 1]; const float nr = pr * cr - pi * ci + er, ni = pr * ci + pi * cr + ei; cr = nr; ci = ni; }
    sr = cr; si = ci;
#pragma unroll
    for (int j = 0; j < 32; ++j) {
        AC[(size_t)j * KC + lane] = (bf16)(cvt_pk_bf16(sr, 0.f) & 0xffffu); AC[(size_t)j * KC + 64 + lane] = (bf16)(cvt_pk_bf16(si, 0.f) & 0xffffu);
        const float nr = ar * sr - ai * si + xr[j], ni = ar * si + ai * sr + xi[j]; sr = nr; si = ni;
    }
    VM_WAIT(); __syncthreads();
}

constexpr int SGU_LDV = 136;
__device__ __forceinline__ void sgu_unit(const Args& a, int n, int h, LAS unsigned char* lds, int tid, int wave, int lane) {
    asm volatile("" : "+v"(tid), "+v"(lane));
    LAS bf16* Vt = (LAS bf16*)lds;
    LAS float* st = (LAS float*)(lds + 36864);
    const int tok0 = n * 128, fr = lane & 15, fq = lane >> 4;
    const bf16* gv = (const bf16*)(a.ws + WS_GV); const bf16* gu = (const bf16*)(a.ws + WS_GU); bf16* Y = (bf16*)(a.ws + WS_Y);
    if (tid < 128) {
        const float* ls = (const float*)(a.ws + WS_LNST) + (size_t)(tok0 + tid) * 32; float s1 = 0.f, s2 = 0.f;
#pragma unroll
        for (int q = 0; q < 8; ++q) { const f32x4 v = *(const f32x4*)(ls + 4 * q); s1 += v[0] + v[2]; s2 += v[1] + v[3]; }
        const float mu = s1 * (1.0f / 1024.0f), var = s2 * (1.0f / 1024.0f) - mu * mu;
        st[tid * 2] = mu; st[tid * 2 + 1] = 1.0f / sqrtf(var + EPS);
    }
    __syncthreads();
#pragma unroll
    for (int i = 0; i < 4; ++i) {
        const int q = tid + 512 * i, s = q & 127, c8 = q >> 7;
        const u32x4 w = *(const u32x4*)(gv + (size_t)(tok0 + s) * DG + h * 128 + 8 * c8);
        f32x4 v0, v1; unpack8(w, v0, v1);
        const f32x4 g0 = *(const f32x4*)(kin(I_LNG) + h * 128 + 8 * c8), g1 = *(const f32x4*)(kin(I_LNG) + h * 128 + 8 * c8 + 4);
        const f32x4 b0 = *(const f32x4*)(kin(I_LNB) + h * 128 + 8 * c8), b1 = *(const f32x4*)(kin(I_LNB) + h * 128 + 8 * c8 + 4);
        const float mu = st[s * 2], rstd = st[s * 2 + 1];
        v0 = (v0 - mu) * rstd * g0 + b0; v1 = (v1 - mu) * rstd * g1 + b1;
        const unsigned p0 = cvt_pk_bf16(v0[0], v0[1]), p1 = cvt_pk_bf16(v0[2], v0[3]), p2 = cvt_pk_bf16(v1[0], v1[1]), p3 = cvt_pk_bf16(v1[2], v1[3]);
        LAS bf16* d = Vt + (8 * c8) * SGU_LDV + s;
        d[0 * SGU_LDV] = (bf16)(p0 & 0xffffu); d[1 * SGU_LDV] = (bf16)(p0 >> 16); d[2 * SGU_LDV] = (bf16)(p1 & 0xffffu); d[3 * SGU_LDV] = (bf16)(p1 >> 16);
        d[4 * SGU_LDV] = (bf16)(p2 & 0xffffu); d[5 * SGU_LDV] = (bf16)(p2 >> 16); d[6 * SGU_LDV] = (bf16)(p3 & 0xffffu); d[7 * SGU_LDV] = (bf16)(p3 >> 16);
    }
    __syncthreads();
    f32x4 acc[8];
#pragma unroll
    for (int j = 0; j < 8; ++j) acc[j] = (f32x4){0.f, 0.f, 0.f, 0.f};
    const int t = 16 * wave + fr;
    const float* wrow = kin(I_SGUW) + ((size_t)h * 128 + t) * 128;
#pragma unroll
    for (int kk = 0; kk < 4; ++kk) {
        if (32 * kk <= 16 * wave + 15) {
            const int s0 = 32 * kk + 8 * fq;
            f32x4 w0 = *(const f32x4*)(wrow + s0), w1 = *(const f32x4*)(wrow + s0 + 4);
#pragma unroll
            for (int q = 0; q < 4; ++q) { if (s0 + q > t) w0[q] = 0.f; if (s0 + 4 + q > t) w1[q] = 0.f; }
            const u32x4 aw = pack8(w0, w1); bf16x8 af; __builtin_memcpy(&af, &aw, 16);
#pragma unroll
            for (int j = 0; j < 8; ++j) {
                const bf16x8 bfr = *(const LAS bf16x8*)(Vt + (16 * j + fr) * SGU_LDV + 32 * kk + 8 * fq);
                acc[j] = __builtin_amdgcn_mfma_f32_16x16x32_bf16(bfr, af, acc[j], 0, 0, 0);
            }
        }
    }
    const float bias = kin(I_SGUB)[h * 128 + t]; float ss = 0.f;
    const size_t tok = (size_t)(tok0 + t);
#pragma unroll
    for (int j = 0; j < 8; ++j) {
        const int c = h * 128 + 16 * j + 4 * fq;
        const u32x2 gw = *(const u32x2*)(gu + tok * DG + c);
        f32x4 o; o[0] = (acc[j][0] + bias) * bf_lo(gw.x); o[1] = (acc[j][1] + bias) * bf_hi(gw.x); o[2] = (acc[j][2] + bias) * bf_lo(gw.y); o[3] = (acc[j][3] + bias) * bf_hi(gw.y);
        ss += (o[0] * o[0] + o[1] * o[1]) + (o[2] * o[2] + o[3] * o[3]);
        u32x2 ow; ow.x = cvt_pk_bf16(o[0], o[1]); ow.y = cvt_pk_bf16(o[2], o[3]);
        *(u32x2*)(Y + tok * D + 1024 + c) = ow;
    }
    ss += __shfl_xor(ss, 16); ss += __shfl_xor(ss, 32);
    if (fq == 0) ((float*)(a.ws + WS_SSQB))[tok * 8 + h] = ss;
    __syncthreads();
}

constexpr int PER_PHASE = 10;
__global__ void __launch_bounds__(NWAVES * 64, 2) hybrid_fwd(Args args) {
    extern __shared__ __attribute__((aligned(16))) unsigned char lds_raw[];
    LAS unsigned char* lds = (LAS unsigned char*)lds_raw;
    volatile LAS unsigned* MISC = (volatile LAS unsigned*)(lds + MISC_OFF);
    const int tid = threadIdx.x, lane = tid & 63, wave = __builtin_amdgcn_readfirstlane(tid >> 6);
    const int G = gridDim.x, bx = blockIdx.x;
    const int vcu = (G % 8 == 0) ? (bx % 8) * (G / 8) + bx / 8 : bx;
    unsigned char* ws = args.ws;
    for (int u = tid; u < (LDS_BYTES - LDSCTL_OFF) / 4; u += NWAVES * 64) ((LAS unsigned*)(lds + LDSCTL_OFF))[u] = 0u;
    __syncthreads();
    XcdBarrier bar; bar.bar = (unsigned*)(ws + WS_CTL) + CW_BAR + args.li * XCD_BAR_WORDS; bar.x = 0; bar.st = nullptr;
    if (MK_N_LAUNCHES != PER_PHASE) bar = xcd_barrier_post((unsigned*)(ws + WS_CTL) + CW_BAR + args.li * XCD_BAR_WORDS, MISC + 8);
    const int lo = args.ph_lo, hi = args.ph_hi;
#ifndef PHASE_MASK
#define PHASE_MASK 0x3ff
#endif
#define IN(k) (((PHASE_MASK >> (k)) & 1) && lo <= (k) && (k) < hi)
#ifndef PROBE_PHASE
#define PROBE_PHASE (-1)
#endif
#define STAMP(k) do { if (PROBE_PHASE >= 0 && bx == 0 && tid == 0) MISC[12 + (k)] = (unsigned)__builtin_amdgcn_s_memrealtime(); } while (0)
#define STAMPX(i) do { if (PROBE_PHASE >= 100 && bx == 0 && tid == 0) MISC[24 + (i)] = (unsigned)__builtin_amdgcn_s_memrealtime(); } while (0)
#define SEAM(k) do { if (IN(k) && IN((k) + 1)) xcd_barrier(bar); STAMP((k) + 1); } while (0)
    STAMP(0);
    const int gw = vcu * NWAVES + wave, ngw = G * NWAVES;
    const bool split = (G == 256);
    const int roleA = split ? (((bx >> 3) & 1) == 0) : 1, roleB = split ? !roleA : 1;
    const int ridx = split ? (((bx >> 4) << 3) | (bx & 7)) : bx, RG = split ? 128 : G;

    bf16* WT_in = (bf16*)(ws + WS_WIN); bf16* WT_glu = (bf16*)(ws + WS_WGLU); bf16* WT_out = (bf16*)(ws + WS_WOUT); bf16* WT_ffi = (bf16*)(ws + WS_WFFI);
    bf16* WT_ffo = (bf16*)(ws + WS_WFFO); bf16* WT_g = (bf16*)(ws + WS_WG); bf16* WT_ple = (bf16*)(ws + WS_WPLE);
    bf16* XB = (bf16*)(ws + WS_XB); bf16* PB = (bf16*)(ws + WS_PB); bf16* AC = (bf16*)(ws + WS_AC);

    if (IN(0)) {
        LAS float* scr = (LAS float*)(lds + wave * 16384);
        if (bx < NG) p0_s5_tables(args, bx, (LAS float*)lds, tid);
        p0_transpose<0>(kin(I_WIN), D, NIN, kin(I_NMIXG), nullptr, WT_in, scr, gw, ngw, lane);
        p0_transpose<0>(kin(I_WPLE), PLE, D, nullptr, nullptr, WT_ple, scr, gw, ngw, lane);
        float* r0 = (float*)(ws + WS_R0);
        for (int m0 = gw; m0 < T; m0 += 4 * ngw) {
            f32x4 v[4][8];
#pragma unroll
            for (int r = 0; r < 4; ++r) { const int m = m0 + r * ngw; if (m < T) { const f32x4* xr = (const f32x4*)(kin(I_X) + (size_t)m * D) + lane;
#pragma unroll
                for (int j = 0; j < 8; ++j) v[r][j] = xr[64 * j]; } }
#pragma unroll
            for (int r = 0; r < 4; ++r) { const int m = m0 + r * ngw; if (m < T) { u32x2* o = (u32x2*)(XB + (size_t)m * D) + lane; float ss = 0.f;
#pragma unroll
                for (int j = 0; j < 8; ++j) { const f32x4 w4 = v[r][j]; ss += (w4[0] * w4[0] + w4[1] * w4[1]) + (w4[2] * w4[2] + w4[3] * w4[3]); u32x2 w; w.x = cvt_pk_bf16(w4[0], w4[1]); w.y = cvt_pk_bf16(w4[2], w4[3]); o[64 * j] = w; }
                ss = wave_sum(ss);
                if (lane == 0) r0[m] = 1.0f / sqrtf(ss * (1.0f / 2048.0f) + EPS); } }
        }
        for (int e = gw * 64 + lane; e < T * PLE / 8; e += ngw * 64) { const f32x4 v0 = *((const f32x4*)kin(I_P) + 2 * e), v1 = *((const f32x4*)kin(I_P) + 2 * e + 1); *((u32x4*)PB + e) = pack8(v0, v1); }
    }
    SEAM(0);
    if (IN(1)) {
        pg8::SchedTiles S; S.init(XB, WT_in + (size_t)DS * D, T, 2 * DG, D, D, G, bx, 4);
        EpiIn E{(const float*)(ws + WS_R0), AC, (bf16*)(ws + WS_GU), (bf16*)(ws + WS_GV), (float*)(ws + WS_LNST)};
        pg8::gemm_phase<EpiIn, pg8::SchedTiles, true>(lds, D, D, D, S, E, tid);
    }
    SEAM(1);
    if (IN(2)) {
        if (roleA) {
            pg8::SchedTiles S; S.init(XB, WT_in, T, DS, D, D, RG, ridx, 0);
            EpiIn E{(const float*)(ws + WS_R0), AC, (bf16*)(ws + WS_GU), (bf16*)(ws + WS_GV), (float*)(ws + WS_LNST)};
            pg8::gemm_phase<EpiIn, pg8::SchedTiles, true>(lds, D, D, D, S, E, tid);
        }
        if (roleB) {
            for (int un = ridx; un < 512; un += RG) sgu_unit(args, un >> 3, un & 7, lds, tid, wave, lane);
        }
    }
    SEAM(2);
    if (IN(3)) {
        if (roleA) {
            for (int un = ridx; un < 2 * NG; un += RG) {
                const int g = un >> 1, b = un & 1;
                pg8::SchedOne S; S.u.A = (const char*)(AC + (size_t)(g * NCH + b * 256) * KC); S.u.pm = b; S.u.pn = 0; S.u.g = g;
                S.u.B = (const char*)((const bf16*)(ws + WS_E) + (size_t)g * 128 * KA);
                EpiSloc E1{(float*)(ws + WS_SLOC)};
                int kA = KA, kC = KC; asm volatile("" : "+s"(kA), "+s"(kC));
                pg8::gemm_phase<EpiSloc, pg8::SchedOne, false>(lds, kA, KC, KA, S, E1, tid);
                VM_WAIT(); __syncthreads();
                s5_scan(args, g, b, lds, wave, lane);
                S.u.B = (const char*)((const bf16*)(ws + WS_TF) + (size_t)g * 256 * KC);
                EpiS5Out E2{AC, kin(I_SD), (bf16*)(ws + WS_YAPRE)};
                pg8::gemm_phase<EpiS5Out, pg8::SchedOne, false>(lds, kC, KC, KC, S, E2, tid);
                __syncthreads();
            }
        }
        if (roleB) {
            pg8::SchedTiles S; S.init(PB, WT_ple, T, D, PLE, PLE, RG, ridx);
            EpiProj E{(bf16*)(ws + WS_PROJ)};
            int kP = PLE; asm volatile("" : "+s"(kP));
            pg8::gemm_phase<EpiProj, pg8::SchedTiles, true>(lds, kP, PLE, PLE, S, E, tid);
            LAS float* scr = (LAS float*)(lds + wave * 16384);
            p0_transpose<0>(kin(I_GLUW), DS, DS, nullptr, nullptr, WT_glu, scr, ridx * NWAVES + wave, RG * NWAVES, lane);
            p0_transpose<0>(kin(I_WOUT), D, D, kin(I_ONSSM), kin(I_ONSGU), WT_out, scr, ridx * NWAVES + wave, RG * NWAVES, lane);
        }
    }
    SEAM(3);
    if (IN(4)) {
        if (roleA) {
            pg8::SchedTiles S; S.init((const bf16*)(ws + WS_YAPRE), WT_glu, T, DS, DS, DS, RG, ridx);
            EpiGlu E{(const bf16*)(ws + WS_YAPRE), kin(I_GLUB), (bf16*)(ws + WS_Y), (float*)(ws + WS_SSQA)};
            pg8::gemm_phase<EpiGlu, pg8::SchedTiles, true>(lds, DS, DS, DS, S, E, tid);
        }
        if (roleB) p0_transpose<1>(kin(I_WFFI), D, 2 * FF, kin(I_NFFNG), nullptr, WT_ffi, (LAS float*)(lds + wave * 16384), ridx * NWAVES + wave, RG * NWAVES, lane);
    }
    SEAM(4);
    if (IN(5)) {
        pg8::SchedTiles S; S.init((const bf16*)(ws + WS_Y), WT_out, T, D, D, D, G, bx);
        EpiOut E{(const float*)(ws + WS_SSQA), (const float*)(ws + WS_SSQB), XB, (float*)(ws + WS_SSQ1)};
        pg8::gemm_phase<EpiOut, pg8::SchedTiles, true>(lds, D, D, D, S, E, tid);
    }
    SEAM(5);
    if (IN(6)) {
        pg8::SchedTiles S; S.init(XB, WT_ffi, T, 2 * FF, D, D, G, bx);
        EpiFfnIn E{(const float*)(ws + WS_SSQ1), (bf16*)(ws + WS_H)};
        pg8::gemm_phase<EpiFfnIn, pg8::SchedTiles, true>(lds, D, D, D, S, E, tid);
        { const int ntile = (T / 256) * (2 * FF / 256), nfull = ntile % G; LAS float* scr = (LAS float*)(lds + wave * 16384);
          const int cgw = (nfull == 0) ? gw : (bx - nfull) * NWAVES + wave, cngw = (nfull == 0) ? ngw : (G - nfull) * NWAVES;
          if (nfull == 0 || bx >= nfull) {
              p0_transpose<0>(kin(I_WFFO), FF, D, nullptr, nullptr, WT_ffo, scr, cgw, cngw, lane);
              p0_transpose<0>(kin(I_WG), D, D, kin(I_NPLEG), nullptr, WT_g, scr, cgw, cngw, lane); } }
    }
    SEAM(6);
    if (IN(7)) {
        pg8::SchedTiles S; S.init((const bf16*)(ws + WS_H), WT_ffo, T, D, FF, FF, G, bx);
        EpiFfnOut E{XB, (float*)(ws + WS_SSQ2)};
        pg8::gemm_phase<EpiFfnOut, pg8::SchedTiles, true>(lds, FF, FF, FF, S, E, tid);
    }
    SEAM(7);
    if (IN(8)) {
        pg8::SchedTiles S; S.init(XB, WT_g, T, D, D, D, G, bx);
        EpiPle E{(const float*)(ws + WS_SSQ2), kin(I_BG), (const bf16*)(ws + WS_PROJ), XB, args.out, (float*)(ws + WS_SSQ3)};
        pg8::gemm_phase<EpiPle, pg8::SchedTiles, true>(lds, D, D, D, S, E, tid);
    }
    SEAM(8);
    if (IN(9)) {
        const float* ssq3 = (const float*)(ws + WS_SSQ3);
        for (int m = gw; m < T; m += ngw) {
            float s = (lane < 32) ? ssq3[(size_t)m * 32 + lane] : 0.f; s = wave_sum(s);
            const float r = 1.0f / sqrtf(s * (1.0f / 2048.0f) + EPS);
            f32x4* xr = (f32x4*)(args.out + (size_t)m * D) + lane; const f32x4* gr = (const f32x4*)kin(I_FNG) + lane;
#pragma unroll
            for (int j = 0; j < 8; ++j) { const f32x4 v = xr[64 * j] * r * gr[64 * j]; xr[64 * j] = v; }
        }
    }
    STAMP(10);
    if (PROBE_PHASE >= 0 && bx == 0 && tid == 0) {
        const unsigned span = (PROBE_PHASE >= 100) ? MISC[24 + PROBE_PHASE - 100 + 1] - MISC[24 + PROBE_PHASE - 100] : MISC[12 + PROBE_PHASE + 1] - MISC[12 + PROBE_PHASE], t9 = MISC[12 + 10];
        while ((unsigned)__builtin_amdgcn_s_memrealtime() - t9 < span) __builtin_amdgcn_s_sleep(8);
    }
#undef IN
#undef SEAM
}

extern "C" void kernel_launch(void* const* d_in, const int* in_sizes, int n_in, void* d_out, int out_size, void* d_ws, size_t ws_size, hipStream_t stream) {
    static int grid = 0;
    if (grid == 0) {
        if (n_in != 29 || in_sizes[0] != T * D || out_size != T * D || ws_size < WS_END) {
            fprintf(stderr, "kernel_launch: shape/workspace mismatch: n_in %d in0 %d out %d ws %zu (need %zu); nothing launched\n", n_in, n_in > 0 ? in_sizes[0] : -1, out_size, ws_size, (size_t)WS_END); grid = -1; return; }
        int dev = 0, cus = 0, per_cu = 0;
        if (hipGetDevice(&dev) != hipSuccess || hipDeviceGetAttribute(&cus, hipDeviceAttributeMultiprocessorCount, dev) != hipSuccess) { fprintf(stderr, "kernel_launch: device query failed\n"); grid = -1; return; }
        if (hipFuncSetAttribute((const void*)hybrid_fwd, hipFuncAttributeMaxDynamicSharedMemorySize, LDS_BYTES) != hipSuccess) { fprintf(stderr, "kernel_launch: hipFuncSetAttribute failed\n"); grid = -1; return; }
        if (hipOccupancyMaxActiveBlocksPerMultiprocessor(&per_cu, (const void*)hybrid_fwd, NWAVES * 64, LDS_BYTES) != hipSuccess || per_cu < 1) { fprintf(stderr, "kernel_launch: occupancy query says %d blocks per CU; nothing launched\n", per_cu); (void)hipGetLastError(); grid = -1; return; }
        grid = cus;
        fprintf(stderr, "kernel_launch: grid %d (CUs %d, occupancy %d/CU), ws need %zu have %zu\n", grid, cus, per_cu, (size_t)WS_END, ws_size);
    }
    if (grid < 0) return;
    if (hipMemsetAsync((char*)d_ws + WS_CTL, 0, CTL_ZERO_BYTES, stream) != hipSuccess) { fprintf(stderr, "kernel_launch: memset failed\n"); return; }
    Args a{};
    for (int i = 0; i < 29; ++i) a.in[i] = (const float*)d_in[i];
    a.out = (float*)d_out; a.ws = (unsigned char*)d_ws;
    if (MK_N_LAUNCHES == 1) {
        a.ph_lo = 0; a.ph_hi = PER_PHASE; a.li = 0;
        void* kargs[] = {&a};
#ifdef PLAIN_LAUNCH
        (void)kargs; hipLaunchKernelGGL(hybrid_fwd, dim3(grid), dim3(NWAVES * 64), LDS_BYTES, stream, a);
        const hipError_t le = hipPeekAtLastError();
#else
        const hipError_t le = hipLaunchCooperativeKernel((const void*)hybrid_fwd, dim3(grid), dim3(NWAVES * 64), kargs, LDS_BYTES, stream);
#endif
        if (le != hipSuccess) fprintf(stderr, "kernel_launch: launch failed: %s (grid %d)\n", hipGetErrorName(le), grid);
    } else {
        for (int li = 0; li < PER_PHASE; ++li) {
            a.ph_lo = li; a.ph_hi = li + 1; a.li = 0;
            hipLaunchKernelGGL(hybrid_fwd, dim3(grid), dim3(NWAVES * 64), LDS_BYTES, stream, a);
            const hipError_t le = hipPeekAtLastError();
            if (le != hipSuccess) { fprintf(stderr, "kernel_launch: launch %d failed: %s\n", li, hipGetErrorName(le)); break; }
        }
    }
}
```
